# Optimizing an MI355X kernel written in HIP

```python
import math
import jax, jax.numpy as jnp
from jax import lax
import numpy as np


D_MODEL = 1024
BATCH = 2
SEQ = 8192
DEPTH = 1
DEC_BATCH = 32
DEC_SEQ = 32
PAST_LEN = 2048

CHUNK = 64
Q_BLOCK = 128
MIX_WIDTH = D_MODEL
ATTN_WIDTH = MIX_WIDTH // 2
POOL_WIDTH = MIX_WIDTH - ATTN_WIDTH
N_HEADS = 4
HEAD_DIM = ATTN_WIDTH // (2 * N_HEADS)
ROT_DIM = HEAD_DIM // 4
ROPE_THETA = 500000.0
POOL_WINDOWS = (2, 4, 8, 16)
N_POOL_GROUPS = len(POOL_WINDOWS)
POOL_GC = POOL_WIDTH // N_POOL_GROUPS
POOL_HIST = max(POOL_WINDOWS) - 1
IN_WIDTH = 4 * ATTN_WIDTH + 2 * POOL_WIDTH
NORM_EPS = 1e-6
SUBLN_EPS = 1e-5
NEG_INF = -1e30

kernel_name = "hybrid_diffattn_pool_stream_step"


def rmsnorm(x, g, eps=NORM_EPS):
    xf = x.astype(jnp.float32)
    y = xf * lax.rsqrt(jnp.mean(xf * xf, axis=-1, keepdims=True) + eps) * g.astype(jnp.float32)
    return y.astype(x.dtype)


def rope(x, pos):
    inv = ROPE_THETA ** (-jnp.arange(0, ROT_DIM, 2, dtype=jnp.float32) / ROT_DIM)
    ang = pos.astype(jnp.float32)[:, None] * inv[None, :]
    cos = jnp.cos(ang)[None, :, None, None, :]
    sin = jnp.sin(ang)[None, :, None, None, :]
    xf = x.astype(jnp.float32)
    a = xf[..., :ROT_DIM // 2]
    b = xf[..., ROT_DIM // 2:ROT_DIM]
    out = jnp.concatenate([a * cos - b * sin, b * cos + a * sin, xf[..., ROT_DIM:]], axis=-1)
    return out.astype(x.dtype)


def _diff_attn_block(qb, qpos_b, k, v, kpos, lam):
    s = jnp.einsum('bqhjd,bkhjd->bhjqk', qb.astype(jnp.float32), k.astype(jnp.float32)) * (HEAD_DIM ** -0.5)
    mask = (kpos[None, :] // CHUNK) <= (qpos_b[:, None] // CHUNK)
    s = jnp.where(mask[None, None, None], s, NEG_INF)
    p = jax.nn.softmax(s, axis=-1)
    a = p[:, :, 0] - lam * p[:, :, 1]
    return jnp.einsum('bhqk,bkhe->bqhe', a, v.astype(jnp.float32))


def diff_attention(q, k, v, qpos, kpos, lam):
    B, S = q.shape[0], q.shape[1]
    if S > Q_BLOCK and S % Q_BLOCK == 0:
        nb = S // Q_BLOCK
        qb = q.reshape(B, nb, Q_BLOCK, N_HEADS, 2, HEAD_DIM).transpose(1, 0, 2, 3, 4, 5)
        pb = qpos.reshape(nb, Q_BLOCK)
        ob = lax.map(lambda args: _diff_attn_block(args[0], args[1], k, v, kpos, lam), (qb, pb))
        return ob.transpose(1, 0, 2, 3, 4).reshape(B, S, N_HEADS, 2 * HEAD_DIM)
    return _diff_attn_block(q, qpos, k, v, kpos, lam)


def pool_mix(u, hist, pos, w_pool, pool_scale):
    B, S, C = u.shape
    uf = u.astype(jnp.float32)
    z = jnp.concatenate([hist.astype(jnp.float32), uf], axis=1)
    c = jnp.concatenate([jnp.zeros((B, 1, C), jnp.float32), jnp.cumsum(z, axis=1)], axis=1)
    end = c[:, POOL_HIST + 1:POOL_HIST + 1 + S]
    means = []
    for g, w in enumerate(POOL_WINDOWS):
        lo, hi = g * POOL_GC, (g + 1) * POOL_GC
        start = c[:, POOL_HIST + 1 - w:POOL_HIST + 1 - w + S, lo:hi]
        cnt = jnp.minimum(pos + 1, w).astype(jnp.float32)[None, :, None]
        means.append((end[..., lo:hi] - start) / cnt)
    m = jnp.concatenate(means, axis=-1) - uf
    m = jnp.einsum('bsgc,gcd->bsgd', m.reshape(B, S, N_POOL_GROUPS, POOL_GC),
                   w_pool.astype(jnp.float32)).reshape(B, S, C)
    return (m * pool_scale.astype(jnp.float32)).astype(u.dtype)


def hybrid_layer(x, pos, k_hist, v_hist, kpos_all, pool_hist, norm_g, w_in, lq1, lk1, lq2, lk2,
                 subln_g, w_pool, pool_scale, w_out, lam_init):
    B, S, _ = x.shape
    h = rmsnorm(x, norm_g)
    proj = jnp.einsum('bsd,de->bse', h, w_in)
    q, k, v, ga, u, gp = jnp.split(proj, [ATTN_WIDTH, 2 * ATTN_WIDTH, 3 * ATTN_WIDTH,
                                          4 * ATTN_WIDTH, 4 * ATTN_WIDTH + POOL_WIDTH], axis=-1)
    q = rope(q.reshape(B, S, N_HEADS, 2, HEAD_DIM), pos)
    k = rope(k.reshape(B, S, N_HEADS, 2, HEAD_DIM), pos)
    k_rows = k.reshape(B, S, N_HEADS, 2 * HEAD_DIM)
    v_rows = v.reshape(B, S, N_HEADS, 2 * HEAD_DIM)
    k_all = jnp.concatenate([k_hist, k_rows], axis=1)
    v_all = jnp.concatenate([v_hist, v_rows], axis=1)
    Lk = k_all.shape[1]
    lam = (jnp.exp(jnp.sum(lq1.astype(jnp.float32) * lk1.astype(jnp.float32)))
           - jnp.exp(jnp.sum(lq2.astype(jnp.float32) * lk2.astype(jnp.float32))) + lam_init)
    o = diff_attention(q, k_all.reshape(B, Lk, N_HEADS, 2, HEAD_DIM), v_all, pos, kpos_all, lam)
    o = rmsnorm(o, subln_g, SUBLN_EPS) * (1.0 - lam_init)
    a_out = o.reshape(B, S, ATTN_WIDTH).astype(x.dtype) * jax.nn.silu(ga)
    p_out = pool_mix(u, pool_hist, pos, w_pool, pool_scale) * jax.nn.silu(gp)
    y = x + jnp.einsum('bse,ed->bsd', jnp.concatenate([a_out, p_out], axis=-1), w_out)
    new_pool = jnp.concatenate([pool_hist.astype(u.dtype), u], axis=1)[:, -POOL_HIST:]
    return y, k_rows, v_rows, new_pool


def setup_inputs(seed: int = 0) -> dict:
    key = jax.random.key(seed)
    ks = jax.random.split(key, 18)
    nrm = jax.random.normal
    f32 = jnp.float32
    return {
        "x_prompt": nrm(ks[0], (BATCH, SEQ, D_MODEL), f32),
        "x_sample": nrm(ks[1], (DEC_BATCH, DEC_SEQ, D_MODEL), f32),
        "cache_k": nrm(ks[2], (DEPTH, DEC_BATCH, PAST_LEN, N_HEADS, 2 * HEAD_DIM), f32),
        "cache_v": nrm(ks[3], (DEPTH, DEC_BATCH, PAST_LEN, N_HEADS, 2 * HEAD_DIM), f32),
        "state_pool": nrm(ks[4], (DEPTH, DEC_BATCH, POOL_HIST, POOL_WIDTH), f32),
        "norm_g": 1.0 + 0.05 * nrm(ks[5], (DEPTH, D_MODEL), f32),
        "w_in": nrm(ks[6], (DEPTH, D_MODEL, IN_WIDTH), f32) * D_MODEL ** -0.5,
        "lambda_q1": 0.1 * nrm(ks[7], (DEPTH, HEAD_DIM), f32),
        "lambda_k1": 0.1 * nrm(ks[8], (DEPTH, HEAD_DIM), f32),
        "lambda_q2": 0.1 * nrm(ks[9], (DEPTH, HEAD_DIM), f32),
        "lambda_k2": 0.1 * nrm(ks[10], (DEPTH, HEAD_DIM), f32),
        "subln_g": 1.0 + 0.05 * nrm(ks[11], (DEPTH, 2 * HEAD_DIM), f32),
        "w_pool": nrm(ks[12], (DEPTH, N_POOL_GROUPS, POOL_GC, POOL_GC), f32) * POOL_GC ** -0.5,
        "pool_scale": 1.0 + 0.05 * nrm(ks[13], (DEPTH, POOL_WIDTH), f32),
        "w_out": nrm(ks[14], (DEPTH, MIX_WIDTH, D_MODEL), f32) * MIX_WIDTH ** -0.5,
        "final_g": 1.0 + 0.05 * nrm(ks[15], (D_MODEL,), f32),
    }


def reference(x_prompt, x_sample, cache_k, cache_v, state_pool, norm_g, w_in, lambda_q1, lambda_k1,
              lambda_q2, lambda_k2, subln_g, w_pool, pool_scale, w_out, final_g):
    B, S, _ = x_prompt.shape
    DB, DS, _ = x_sample.shape
    L = cache_k.shape[2]
    pos_p = jnp.arange(S, dtype=jnp.int32)
    pos_s = L + jnp.arange(DS, dtype=jnp.int32)
    kpos_s = jnp.concatenate([jnp.arange(L, dtype=jnp.int32), pos_s])
    xp, xs = x_prompt, x_sample
    kp_l, vp_l, pp_l, ks_l, vs_l, ps_l = [], [], [], [], [], []
    for l in range(DEPTH):
        lam_init = 0.8 - 0.6 * math.exp(-0.3 * l)
        shared = (norm_g[l], w_in[l], lambda_q1[l], lambda_k1[l], lambda_q2[l], lambda_k2[l],
                  subln_g[l], w_pool[l], pool_scale[l], w_out[l], lam_init)
        empty_kv = jnp.zeros((B, 0, N_HEADS, 2 * HEAD_DIM), xp.dtype)
        zero_pool = jnp.zeros((B, POOL_HIST, POOL_WIDTH), xp.dtype)
        xp, kp, vp, pp = hybrid_layer(xp, pos_p, empty_kv, empty_kv, pos_p, zero_pool, *shared)
        xs, kn, vn, pn = hybrid_layer(xs, pos_s, cache_k[l], cache_v[l], kpos_s, state_pool[l], *shared)
        kp_l.append(kp); vp_l.append(vp); pp_l.append(pp)
        ks_l.append(kn); vs_l.append(vn); ps_l.append(pn)
    y_prompt = rmsnorm(xp, final_g)
    y_sample = rmsnorm(xs, final_g)
    k_prompt = jnp.stack(kp_l, axis=0)
    v_prompt = jnp.stack(vp_l, axis=0)
    pool_prompt = jnp.stack(pp_l, axis=0)
    k_sample = jnp.stack(ks_l, axis=0)
    v_sample = jnp.stack(vs_l, axis=0)
    pool_sample = jnp.stack(ps_l, axis=0)
    return (y_prompt, y_sample, k_prompt, v_prompt, pool_prompt, k_sample, v_sample, pool_sample)
```

```cpp
#include <hip/hip_runtime.h>
#include <hip/hip_cooperative_groups.h>
#include <cstdio>
namespace cg = cooperative_groups;

#ifndef NLAUNCH
#define NLAUNCH 1
#endif

#define LAS __attribute__((address_space(3)))
#define DI __device__ __forceinline__
typedef __attribute__((ext_vector_type(8))) short bf16x8;
typedef __attribute__((ext_vector_type(4))) short s16x4;
typedef __attribute__((ext_vector_type(16))) float f32x16;
typedef __attribute__((ext_vector_type(4))) float f32x4;
typedef __attribute__((ext_vector_type(2))) float f32x2;
typedef __attribute__((ext_vector_type(4))) unsigned u32x4;
typedef __attribute__((ext_vector_type(2))) unsigned u32x2;
typedef __attribute__((ext_vector_type(2))) __bf16 bf16x2_t;
typedef unsigned short bf16_t;
typedef LAS unsigned char* ldsp;

#define MFMA(a, b, c) __builtin_amdgcn_mfma_f32_32x32x16_bf16((a), (b), (c), 0, 0, 0)

constexpr int DM = 1024, SEQ = 8192, MP = 16384, MS = 1024, MT = MP + MS, NIN = 3072;
constexpr size_t MiB = 1u << 20;
constexpr int HP = 1088, QP = 576;
constexpr size_t WS_WINT = 0, WS_WOUTT = 8 * MiB, WS_WPT = 11 * MiB, WS_ROPE = 12 * MiB, WS_HB = 16 * MiB;
constexpr size_t WS_Q = 56 * MiB, WS_SEG = 20 * MiB;
constexpr size_t WS_K = WS_Q + WS_SEG, WS_V = WS_Q + 2 * WS_SEG, WS_GA = WS_Q + 3 * WS_SEG, WS_U = WS_Q + 4 * WS_SEG, WS_GP = WS_Q + 5 * WS_SEG;
constexpr size_t WS_MIX = 176 * MiB;
constexpr size_t WS_BAR = 255 * MiB;
constexpr int BAR_REGION_WORDS = 4096;
constexpr size_t WS_YPRE = 256 * MiB;
constexpr size_t O_Y = 0, O_KP = 17825792, O_VP = 26214400, O_PP = 34603008, O_KS = 34618368, O_VS = 35142656, O_PS = 35666944;
constexpr float QSCALE = 0.125f * 1.4426950408889634f;
constexpr int LDS_BYTES = 147456;

struct Params {
  const float *x_prompt, *x_sample, *cache_k, *cache_v, *state_pool, *norm_g, *w_in, *lq1, *lk1, *lq2, *lk2, *subln_g, *w_pool, *pool_scale, *w_out, *final_g;
  float* out; unsigned char* ws; int ph_lo, ph_hi, bar_idx, p2mask, mode, pad;
};

DI unsigned pk2(float lo, float hi) { f32x2 v = {lo, hi}; bf16x2_t b = __builtin_convertvector(v, bf16x2_t); return __builtin_bit_cast(unsigned, b); }
DI float bflo(unsigned u) { return __uint_as_float(u << 16); }
DI float bfhi(unsigned u) { return __uint_as_float(u & 0xffff0000u); }
DI float wave_sum(float v) {
#pragma unroll
  for (int o = 32; o; o >>= 1) v += __shfl_xor(v, o);
  return v;
}
DI int crow(int i, int h) { return (i & 3) + 8 * (i >> 2) + 4 * h; }
DI float silu(float v) { return v * __builtin_amdgcn_rcpf(1.f + __builtin_amdgcn_exp2f(-1.4426950408889634f * v)); }
DI int row_pos(int row) { return row < MP ? (row & (SEQ - 1)) : 2048 + ((row - MP) & 31); }
DI const float* x_row(const Params& p, int row) { return row < MP ? p.x_prompt + (size_t)row * DM : p.x_sample + (size_t)(row - MP) * DM; }

DI void phase0(const Params& p, ldsp lds, const int tid) {
  const int wave = tid >> 6, lane = tid & 63;
  const int G = gridDim.x, bid = blockIdx.x;
  bf16_t* WinT = (bf16_t*)(p.ws + WS_WINT);
  bf16_t* WoutT = (bf16_t*)(p.ws + WS_WOUTT);
  bf16_t* WpT = (bf16_t*)(p.ws + WS_WPT);
  for (int it = bid * 8 + wave; it < 1040 * 8; it += G * 8) {
    const int t = it >> 3, sub = it & 7;
    const float* W; bf16_t* WT; int ldw, ldt, k0, n0;
    if (t < 768) { W = p.w_in; WT = WinT; ldw = NIN; ldt = HP; k0 = (t / 48) * 64; n0 = (t % 48) * 64; }
    else if (t < 1024) { const int u = t - 768; W = p.w_out; WT = WoutT; ldw = DM; ldt = HP; k0 = (u >> 4) * 64; n0 = (u & 15) * 64; }
    else { const int u = t - 1024; const int g = u >> 2; W = p.w_pool + g * 16384; WT = WpT + g * 16384; ldw = 128; ldt = 128; k0 = ((u >> 1) & 1) * 64; n0 = (u & 1) * 64; }
    const float* src = W + (size_t)(k0 + lane) * ldw + n0 + sub * 8;
    const f32x4 a0 = *(const f32x4*)src, a1 = *(const f32x4*)(src + 4);
    bf16_t* dstp = WT + (size_t)(n0 + sub * 8) * ldt + k0 + lane;
    dstp[0 * (size_t)ldt] = (bf16_t)pk2(a0[0], 0.f); dstp[1 * (size_t)ldt] = (bf16_t)pk2(a0[1], 0.f);
    dstp[2 * (size_t)ldt] = (bf16_t)pk2(a0[2], 0.f); dstp[3 * (size_t)ldt] = (bf16_t)pk2(a0[3], 0.f);
    dstp[4 * (size_t)ldt] = (bf16_t)pk2(a1[0], 0.f); dstp[5 * (size_t)ldt] = (bf16_t)pk2(a1[1], 0.f);
    dstp[6 * (size_t)ldt] = (bf16_t)pk2(a1[2], 0.f); dstp[7 * (size_t)ldt] = (bf16_t)pk2(a1[3], 0.f);
  }
  {
    bf16_t* Hb = (bf16_t*)(p.ws + WS_HB);
    for (int row = bid * 8 + wave; row < MT; row += G * 32) {
      f32x4 v[4][4]; float ss[4];
#pragma unroll
      for (int q = 0; q < 4; ++q) {
        const int rw = row + q * G * 8;
        const float* x = x_row(p, rw < MT ? rw : row);
#pragma unroll
        for (int i = 0; i < 4; ++i) v[q][i] = *(const f32x4*)(x + lane * 4 + 256 * i);
      }
#pragma unroll
      for (int q = 0; q < 4; ++q) {
        float a = 0.f;
#pragma unroll
        for (int i = 0; i < 4; ++i) a += v[q][i][0] * v[q][i][0] + v[q][i][1] * v[q][i][1] + v[q][i][2] * v[q][i][2] + v[q][i][3] * v[q][i][3];
        ss[q] = rsqrtf(wave_sum(a) * (1.f / DM) + 1e-6f);
      }
#pragma unroll
      for (int i = 0; i < 4; ++i) {
        const f32x4 g = *(const f32x4*)(p.norm_g + lane * 4 + 256 * i);
#pragma unroll
        for (int q = 0; q < 4; ++q) {
          const int rw = row + q * G * 8;
          if (rw < MT) {
            const float rs = ss[q];
            u32x2 w = {pk2(v[q][i][0] * rs * g[0], v[q][i][1] * rs * g[1]), pk2(v[q][i][2] * rs * g[2], v[q][i][3] * rs * g[3])};
            *(u32x2*)(Hb + (size_t)rw * HP + lane * 4 + 256 * i) = w;
          }
        }
      }
    }
  }
}

constexpr int BK = 64, LDP = 144;

template <int BM, int WGM, class Epi>
DI void gemm_phase(const bf16_t* __restrict__ A, const bf16_t* __restrict__ Bt, const int Mrows, const int N, const int K, ldsp lds, const int tid, const Epi& epi) {
  constexpr int BN = 256, A_BYTES = BM * LDP, STAGE = (BM + BN) * LDP, NA = BM / 64, WROWS = BM / WGM, WCOLS = BN / (8 / WGM), TM = WROWS / 32, TN = WCOLS / 32;
  const int wave = tid >> 6, lane = tid & 63, r = lane & 31, h = lane >> 5, wm = wave % WGM, wn = wave / WGM;
  const int tiles_n = N / BN, ntiles = (Mrows / BM) * tiles_n, nk = K / BK;
  const int lrow = tid >> 3, lc = tid & 7;
  for (int t = blockIdx.x; t < ntiles; t += gridDim.x) {
    const int m0 = (t / tiles_n) * BM, n0 = (t % tiles_n) * BN;
    const bf16_t* ag = A + (size_t)(m0 + lrow) * K + lc * 8;
    const bf16_t* bg = Bt + (size_t)(n0 + lrow) * K + lc * 8;
    u32x4 ra[NA], rb[4];
    f32x16 acc[TM][TN];
#pragma unroll
    for (int a = 0; a < TM; ++a)
#pragma unroll
      for (int b = 0; b < TN; ++b)
#pragma unroll
        for (int i = 0; i < 16; ++i) acc[a][b][i] = 0.f;
#pragma unroll
    for (int i = 0; i < NA; ++i) ra[i] = *(const u32x4*)(ag + (size_t)i * 64 * K);
#pragma unroll
    for (int i = 0; i < 4; ++i) rb[i] = *(const u32x4*)(bg + (size_t)i * 64 * K);
#pragma unroll
    for (int i = 0; i < NA; ++i) *(LAS u32x4*)(lds + (lrow + 64 * i) * LDP + lc * 16) = ra[i];
#pragma unroll
    for (int i = 0; i < 4; ++i) *(LAS u32x4*)(lds + A_BYTES + (lrow + 64 * i) * LDP + lc * 16) = rb[i];
    __syncthreads();
    for (int kt = 0; kt < nk; ++kt) {
      const bool more = kt + 1 < nk;
      if (more) {
#pragma unroll
        for (int i = 0; i < NA; ++i) ra[i] = *(const u32x4*)(ag + (size_t)i * 64 * K + (kt + 1) * BK);
#pragma unroll
        for (int i = 0; i < 4; ++i) rb[i] = *(const u32x4*)(bg + (size_t)i * 64 * K + (kt + 1) * BK);
      }
      const ldsp sa = lds + (kt & 1) * STAGE + (wm * WROWS + r) * LDP + h * 16;
      const ldsp sb = lds + (kt & 1) * STAGE + A_BYTES + (wn * WCOLS + r) * LDP + h * 16;
#pragma unroll
      for (int ks = 0; ks < 4; ++ks) {
        bf16x8 af[TM], bfr[TN];
#pragma unroll
        for (int a = 0; a < TM; ++a) af[a] = *(const LAS bf16x8*)(sa + a * 32 * LDP + ks * 32);
#pragma unroll
        for (int b = 0; b < TN; ++b) bfr[b] = *(const LAS bf16x8*)(sb + b * 32 * LDP + ks * 32);
#pragma unroll
        for (int a = 0; a < TM; ++a)
#pragma unroll
          for (int b = 0; b < TN; ++b) acc[a][b] = MFMA(af[a], bfr[b], acc[a][b]);
      }
      if (more) {
        const ldsp wbase = lds + ((kt + 1) & 1) * STAGE;
#pragma unroll
        for (int i = 0; i < NA; ++i) *(LAS u32x4*)(wbase + (lrow + 64 * i) * LDP + lc * 16) = ra[i];
#pragma unroll
        for (int i = 0; i < 4; ++i) *(LAS u32x4*)(wbase + A_BYTES + (lrow + 64 * i) * LDP + lc * 16) = rb[i];
      }
      __syncthreads();
    }
#pragma unroll
    for (int a = 0; a < TM; ++a)
#pragma unroll
      for (int b = 0; b < TN; ++b) epi(acc[a][b], m0 + wm * WROWS + a * 32, n0 + wn * WCOLS + b * 32, r, h);
  }
}


#define GAS __attribute__((address_space(1)))
DI void glds16(const void* g, ldsp l) { __builtin_amdgcn_global_load_lds((const GAS unsigned*)g, (LAS unsigned*)l, 16, 0, 0); }
template <int N> DI void wait_vm() { asm volatile("s_waitcnt vmcnt(%0)" ::"n"(N) : "memory"); }
DI void raw_barrier() { asm volatile("s_waitcnt lgkmcnt(0)" ::: "memory"); __builtin_amdgcn_s_barrier(); }

template <int PER, int MAXS> DI void wait_stages(const int rem) {
  if (rem >= MAXS) wait_vm<MAXS * PER>();
  else if constexpr (MAXS > 0) wait_stages<PER, MAXS - 1>(rem);
}

template <int BM, int WGM, int NS, class Epi, bool REV = false>
DI void gemm_glds(const bf16_t* __restrict__ A, const bf16_t* __restrict__ Bt, const int row0, const int Mrows, const int N, const int K, ldsp lds, const int tid, const Epi& epi, const int mode) {
  constexpr int BN = 256, A_BYTES = BM * 64, STAGE = (BM + BN) * 64;
  static_assert(NS * STAGE <= LDS_BYTES - 64, "LDS ring too large");
  constexpr int WGN = 8 / WGM, WROWS = BM / WGM, WCOLS = BN / WGN, TM = WROWS / 32, TN = WCOLS / 32, NAI = (BM >= 128) ? BM / 128 : 1, AW = (BM >= 128) ? 8 : BM / 16, PER = NAI + 2;
  const int wave = __builtin_amdgcn_readfirstlane(tid >> 6), lane = tid & 63, r = lane & 31, h = lane >> 5, wm = wave % WGM, wn = wave / WGM;
  const int tiles_n = N / BN, ntiles = (Mrows / BM) * tiles_n, nk = K / 32;
  const int lr = lane >> 2, lchunk = (lane & 3) ^ ((lr >> 2) & 3);
  const int swz = (r >> 2) & 3;
  for (int t = REV ? (int)(gridDim.x - 1 - blockIdx.x) : (int)blockIdx.x; t < ntiles; t += gridDim.x) {
    const int m0 = row0 + (t / tiles_n) * BM, n0 = (t % tiles_n) * BN;
    const bf16_t* ga = A + (size_t)(m0 + (wave % AW) * NAI * 16 + lr) * HP + lchunk * 8;
    const bf16_t* gb = Bt + (size_t)(n0 + wave * 32 + lr) * HP + lchunk * 8;
    const ldsp la = lds + (wave % AW) * NAI * 1024, lb = lds + A_BYTES + wave * 2048;
    f32x16 acc[TM][TN];
#pragma unroll
    for (int a = 0; a < TM; ++a)
#pragma unroll
      for (int b = 0; b < TN; ++b)
#pragma unroll
        for (int i = 0; i < 16; ++i) acc[a][b][i] = 0.f;
#define GEMM_ISSUE(kt_, slot_) do { const int st_ = (slot_) * STAGE; \
      _Pragma("unroll") for (int i_ = 0; i_ < NAI; ++i_) glds16(ga + (size_t)i_ * 16 * HP + (kt_) * 32, la + st_ + i_ * 1024); \
      _Pragma("unroll") for (int i_ = 0; i_ < 2; ++i_) glds16(gb + (size_t)i_ * 16 * HP + (kt_) * 32, lb + st_ + i_ * 1024); } while (0)
#pragma unroll
    for (int i = 0; i < NS - 1; ++i) GEMM_ISSUE(i, i);
    int rs_ = 0, ws_ = NS - 1;
    for (int kt = 0; kt < nk; ++kt) {
      wait_stages<PER, NS - 2>(nk - 1 - kt);
      raw_barrier();
      if (kt + NS - 1 < nk) GEMM_ISSUE(kt + NS - 1, ws_);
      const ldsp sa = lds + rs_ * STAGE + (wm * WROWS + r) * 64;
      const ldsp sb = lds + rs_ * STAGE + A_BYTES + (wn * WCOLS + r) * 64;
      rs_ = (rs_ + 1 == NS) ? 0 : rs_ + 1; ws_ = (ws_ + 1 == NS) ? 0 : ws_ + 1;
#pragma unroll
      for (int ks = 0; ks < 2; ++ks) {
        const int co = ((ks * 2 + h) ^ swz) * 16;
        bf16x8 af[TM], bfr[TN];
#pragma unroll
        for (int a = 0; a < TM; ++a) af[a] = *(const LAS bf16x8*)(sa + a * 2048 + co);
#pragma unroll
        for (int b = 0; b < TN; ++b) bfr[b] = *(const LAS bf16x8*)(sb + b * 2048 + co);
#pragma unroll
        for (int a = 0; a < TM; ++a)
#pragma unroll
          for (int b = 0; b < TN; ++b) acc[a][b] = MFMA(af[a], bfr[b], acc[a][b]);
      }
    }
#undef GEMM_ISSUE
    if constexpr (Epi::KIND == 1) {
      raw_barrier();
#pragma unroll
      for (int a = 0; a < TM; ++a) epi.template rowblock<TN>(acc[a], m0 + wm * WROWS + a * 32, n0 + wn * WCOLS, lane, lds + wave * 16896);
    } else {
      static_assert(TN == 2, "64-column wave-tile epilogue");
      raw_barrier();
      epi.template tile64<TM>(acc, m0 + wm * WROWS, n0 + wn * WCOLS, lane, lds + wave * 17408);
    }
    raw_barrier();
  }
}

struct EpiIn {
  static constexpr int KIND = 1;
  const float* rope; float* out; unsigned char* ws;
  template <int TN>
  DI void rowblock(const f32x16* acc, const int mb, const int nb0, const int lane, ldsp wl) const {
    constexpr int SP = TN * 32 + 4, LPR = TN * 2, RPP = 64 / LPR, NP = 32 / RPP;
    const int r = lane & 31, h = lane >> 5;
    LAS float* st = (LAS float*)wl;
#pragma unroll
    for (int b = 0; b < TN; ++b)
#pragma unroll
      for (int i = 0; i < 16; ++i) st[crow(i, h) * SP + b * 32 + r] = acc[b][i];
    const int seg = nb0 >> 9, c0 = nb0 & 511;
    bf16_t* dst = (bf16_t*)(ws + WS_Q + (size_t)seg * WS_SEG);
    const int cg = lane % LPR, col_l = cg * 16;
#pragma unroll 2
    for (int pass = 0; pass < NP; ++pass) {
      const int row_l = pass * RPP + (lane / LPR);
      const int row = mb + row_l, c = c0 + col_l;
      f32x4 v[4];
#pragma unroll
      for (int k = 0; k < 4; ++k) v[k] = *(const LAS f32x4*)(st + row_l * SP + col_l + 4 * k);
      if (seg < 2 && (col_l & 63) == 0) {
        const float fpos = (float)row_pos(row);
        const float rc[8] = {0.15915494309189535f, 0.03086376340470123f, 0.005985185712713705f, 0.001160663641240061f, 0.00022507907903927653f, 4.364795279280289e-05f, 8.464330808241401e-06f, 1.6414262627950345e-06f};
        float cs[16];
#pragma unroll
        for (int i = 0; i < 8; ++i) { const float fr = __builtin_amdgcn_fractf(fpos * rc[i]); cs[2 * i] = __builtin_amdgcn_cosf(fr); cs[2 * i + 1] = __builtin_amdgcn_sinf(fr); }
#pragma unroll
        for (int i = 0; i < 8; ++i) {
          const float a = v[i >> 2][i & 3], bb = v[2 + (i >> 2)][i & 3];
          v[i >> 2][i & 3] = a * cs[2 * i] - bb * cs[2 * i + 1];
          v[2 + (i >> 2)][i & 3] = bb * cs[2 * i] + a * cs[2 * i + 1];
        }
      }
      if (seg == 0) {
#pragma unroll
        for (int k = 0; k < 4; ++k) v[k] *= QSCALE;
      } else if (seg == 1 || seg == 2) {
        float* o = (row < MP) ? out + (seg == 1 ? O_KP : O_VP) + (size_t)row * 512 + c : out + (seg == 1 ? O_KS : O_VS) + (size_t)(row - MP) * 512 + c;
#pragma unroll
        for (int k = 0; k < 4; ++k) *(f32x4*)(o + 4 * k) = v[k];
      } else if (seg == 3 || seg == 5) {
#pragma unroll
        for (int k = 0; k < 4; ++k)
#pragma unroll
          for (int e = 0; e < 4; ++e) v[k][e] = silu(v[k][e]);
      } else {
        float* o = nullptr;
        if (row < MP) { const int s = row & (SEQ - 1); if (s >= SEQ - 15) o = out + O_PP + ((size_t)(row >> 13) * 15 + (s - (SEQ - 15))) * 512 + c; }
        else { const int s = (row - MP) & 31; if (s >= 17) o = out + O_PS + ((size_t)((row - MP) >> 5) * 15 + (s - 17)) * 512 + c; }
        if (o) {
#pragma unroll
          for (int k = 0; k < 4; ++k) *(f32x4*)(o + 4 * k) = v[k];
        }
      }
      const u32x4 w0 = {pk2(v[0][0], v[0][1]), pk2(v[0][2], v[0][3]), pk2(v[1][0], v[1][1]), pk2(v[1][2], v[1][3])};
      const u32x4 w1 = {pk2(v[2][0], v[2][1]), pk2(v[2][2], v[2][3]), pk2(v[3][0], v[3][1]), pk2(v[3][2], v[3][3])};
      *(u32x4*)(dst + (size_t)row * QP + c) = w0;
      *(u32x4*)(dst + (size_t)row * QP + c + 8) = w1;
    }
  }
  DI void operator()(const f32x16& acc, const int mb, const int nb, const int r, const int h) const {
    const int seg = nb >> 9;
    const int c = (nb & 511) + r;
    bf16_t* dst = (bf16_t*)(ws + WS_Q + (size_t)seg * WS_SEG);
    const bool do_rope = (seg < 2) && ((nb & 63) == 0);
#pragma unroll
    for (int i = 0; i < 16; ++i) {
      const int row = mb + crow(i, h);
      float v = acc[i];
      if (do_rope) {
        const float pv = __shfl_xor(v, 8);
        if (r < 16) {
          const f32x2 cs = *(const f32x2*)(rope + ((size_t)row_pos(row) * 8 + (r & 7)) * 2);
          v = (r < 8) ? (v * cs[0] - pv * cs[1]) : (v * cs[0] + pv * cs[1]);
        }
      }
      if (seg == 0) {
        dst[(size_t)row * QP + c] = (bf16_t)pk2(v * QSCALE, 0.f);
      } else if (seg == 1 || seg == 2) {
        float* o = (row < MP) ? out + (seg == 1 ? O_KP : O_VP) + (size_t)row * 512 + c : out + (seg == 1 ? O_KS : O_VS) + (size_t)(row - MP) * 512 + c;
        *o = v;
        dst[(size_t)row * QP + c] = (bf16_t)pk2(v, 0.f);
      } else if (seg == 3 || seg == 5) {
        dst[(size_t)row * QP + c] = (bf16_t)pk2(silu(v), 0.f);
      } else {
        dst[(size_t)row * QP + c] = (bf16_t)pk2(v, 0.f);
        if (row < MP) {
          const int s = row & (SEQ - 1);
          if (s >= SEQ - 15) out[O_PP + ((size_t)(row >> 13) * 15 + (s - (SEQ - 15))) * 512 + c] = v;
        } else {
          const int s = (row - MP) & 31;
          if (s >= 17) out[O_PS + ((size_t)((row - MP) >> 5) * 15 + (s - 17)) * 512 + c] = v;
        }
      }
    }
  }
};

struct EpiOut {
  static constexpr int KIND = 2;
  const float* xp; const float* xs; bf16_t* out;
  template <int TM>
  DI void tile64(const f32x16 (&acc)[TM][2], const int mb, const int nb, const int lane, ldsp wl) const {
    const int r = lane & 31, h = lane >> 5;
    LAS float* st = (LAS float*)wl;
    const int rq = lane >> 4, c4 = (lane & 15) * 4;
    f32x4 xv[TM * 8];
#pragma unroll
    for (int ps = 0; ps < TM * 8; ++ps) {
      const int row = mb + ps * 4 + rq;
      const float* x = row < MP ? xp + (size_t)row * DM : xs + (size_t)(row - MP) * DM;
      xv[ps] = *(const f32x4*)(x + nb + c4);
    }
#pragma unroll
    for (int a = 0; a < TM; ++a)
#pragma unroll
      for (int b = 0; b < 2; ++b)
#pragma unroll
        for (int i = 0; i < 16; ++i) st[(a * 32 + crow(i, h)) * 68 + b * 32 + r] = acc[a][b][i];
#pragma unroll
    for (int ps = 0; ps < TM * 8; ++ps) {
      const int row = mb + ps * 4 + rq;
      const f32x4 v = *(const LAS f32x4*)(st + (ps * 4 + rq) * 68 + c4);
      const f32x4 y4 = v + xv[ps];
      const u32x2 yb = {pk2(y4[0], y4[1]), pk2(y4[2], y4[3])};
      *(u32x2*)(out + (size_t)row * HP + nb + c4) = yb;
    }
  }
};

constexpr int KP = 272, VP = 320, ASTG = 64 * KP + 64 * VP;

DI s16x4 vtr(ldsp p) { return __builtin_bit_cast(s16x4, __builtin_amdgcn_ds_read_tr16_b64_v4i16((LAS s16x4*)p)); }

template <bool SAMPLE>
DI void attn_unit(const Params& p, ldsp lds, const int tid, const float lam, const int b, const int hd, const int x) {
  const int wave = tid >> 6, lane = tid & 63, r = lane & 31, h = lane >> 5, rs = wave & 3, j = wave >> 2;
  const bf16_t* Qb = (const bf16_t*)(p.ws + WS_Q);
  const bf16_t* Kb = (const bf16_t*)(p.ws + WS_K);
  const bf16_t* Vb = (const bf16_t*)(p.ws + WS_V);
  const bf16_t* Ga = (const bf16_t*)(p.ws + WS_GA);
  bf16_t* Mix = (bf16_t*)(p.ws + WS_MIX);
  const int nt = SAMPLE ? 33 : 2 * x + 2;
  const int my_nt = SAMPLE ? 33 : 2 * x + 1 + (rs >> 1);
  const bool active = SAMPLE ? (rs == 0) : true;
  const int row0 = SAMPLE ? MP + b * 32 : b * SEQ + x * 128;
  const int qrow = row0 + (SAMPLE ? 0 : 32 * rs) + r;
  bf16x8 qf[4];
#pragma unroll
  for (int ks = 0; ks < 4; ++ks) qf[ks] = *(const bf16x8*)(Qb + (size_t)qrow * QP + hd * 128 + j * 64 + ks * 16 + h * 8);
  f32x16 O[4];
#pragma unroll
  for (int d = 0; d < 4; ++d)
#pragma unroll
    for (int i = 0; i < 16; ++i) O[d][i] = 0.f;
  float m = -1e30f, l = 0.f;
  const int lrow = tid >> 4, lc = tid & 15;
  if (SAMPLE) {
    u32x4 kv = {0u, 0u, 0u, 0u}, vv = {0u, 0u, 0u, 0u};
    kv = *(const u32x4*)(Kb + (size_t)(MP + b * 32 + lrow) * QP + hd * 128 + lc * 8);
    vv = *(const u32x4*)(Vb + (size_t)(MP + b * 32 + lrow) * QP + hd * 128 + lc * 8);
    const u32x4 z = {0u, 0u, 0u, 0u};
    *(LAS u32x4*)(lds + lrow * KP + lc * 16) = kv;
    *(LAS u32x4*)(lds + 64 * KP + lrow * VP + lc * 16) = vv;
    *(LAS u32x4*)(lds + (lrow + 32) * KP + lc * 16) = z;
    *(LAS u32x4*)(lds + 64 * KP + (lrow + 32) * VP + lc * 16) = z;
  } else {
#pragma unroll
    for (int i = 0; i < 2; ++i) {
      const size_t kr = (size_t)(b * SEQ + lrow + 32 * i) * QP + hd * 128 + lc * 8;
      const u32x4 kv = *(const u32x4*)(Kb + kr);
      const u32x4 vv = *(const u32x4*)(Vb + kr);
      *(LAS u32x4*)(lds + (lrow + 32 * i) * KP + lc * 16) = kv;
      *(LAS u32x4*)(lds + 64 * KP + (lrow + 32 * i) * VP + lc * 16) = vv;
    }
  }
  __syncthreads();
  const int i16 = lane & 15, q4 = i16 >> 2, p4 = i16 & 3, blk = (lane >> 4) & 1;
  for (int t = 0; t < nt; ++t) {
    const bool more = t + 1 < nt;
    u32x4 sk[2], sv[2];
    f32x4 fk[4], fv[4];
    if (more) {
      if (SAMPLE) {
#pragma unroll
        for (int i = 0; i < 2; ++i) {
          const size_t src = (((size_t)b * 2048 + (size_t)t * 64 + lrow + 32 * i) * 4 + hd) * 128 + lc * 8;
          fk[2 * i] = *(const f32x4*)(p.cache_k + src); fk[2 * i + 1] = *(const f32x4*)(p.cache_k + src + 4);
          fv[2 * i] = *(const f32x4*)(p.cache_v + src); fv[2 * i + 1] = *(const f32x4*)(p.cache_v + src + 4);
        }
      } else {
#pragma unroll
        for (int i = 0; i < 2; ++i) {
          const size_t kr = (size_t)(b * SEQ + (t + 1) * 64 + lrow + 32 * i) * QP + hd * 128 + lc * 8;
          sk[i] = *(const u32x4*)(Kb + kr);
          sv[i] = *(const u32x4*)(Vb + kr);
        }
      }
    }
    if (active && t < my_nt) {
      const ldsp Kl = lds + (t & 1) * ASTG, Vl = Kl + 64 * KP;
      f32x16 S[2];
#pragma unroll
      for (int kb = 0; kb < 2; ++kb) {
#pragma unroll
        for (int i = 0; i < 16; ++i) S[kb][i] = 0.f;
#pragma unroll
        for (int ks = 0; ks < 4; ++ks) {
          const bf16x8 kf = *(const LAS bf16x8*)(Kl + (32 * kb + r) * KP + (j * 64 + 16 * ks + 8 * h) * 2);
          S[kb] = MFMA(kf, qf[ks], S[kb]);
        }
      }
      if (SAMPLE && t == 0) {
#pragma unroll
        for (int i = 0; i < 16; ++i) S[1][i] = -1e30f;
      }
      float mx = S[0][0];
#pragma unroll
      for (int i = 1; i < 16; ++i) mx = fmaxf(mx, S[0][i]);
#pragma unroll
      for (int i = 0; i < 16; ++i) mx = fmaxf(mx, S[1][i]);
      mx = fmaxf(mx, __shfl_xor(mx, 32));
      const float mnew = fmaxf(m, mx);
      if (__any(mx > m + 6.f)) {
        const float alpha = __builtin_amdgcn_exp2f(m - mnew);
#pragma unroll
        for (int d = 0; d < 4; ++d)
#pragma unroll
          for (int i = 0; i < 16; ++i) O[d][i] *= alpha;
        l *= alpha; m = mnew;
      }
      float ls = 0.f;
#pragma unroll
      for (int kb = 0; kb < 2; ++kb)
#pragma unroll
        for (int i = 0; i < 16; ++i) { const float pp = __builtin_amdgcn_exp2f(S[kb][i] - m); S[kb][i] = pp; ls += pp; }
      l += ls;
#pragma unroll
      for (int kb = 0; kb < 2; ++kb)
#pragma unroll
        for (int s = 0; s < 2; ++s) {
          u32x4 pu = {pk2(S[kb][8 * s + 0], S[kb][8 * s + 1]), pk2(S[kb][8 * s + 2], S[kb][8 * s + 3]), pk2(S[kb][8 * s + 4], S[kb][8 * s + 5]), pk2(S[kb][8 * s + 6], S[kb][8 * s + 7])};
          const bf16x8 pf = __builtin_bit_cast(bf16x8, pu);
          const ldsp vb = Vl + (32 * kb + 16 * s + 4 * h + q4) * VP + blk * 32 + p4 * 8;
#pragma unroll
          for (int d = 0; d < 4; ++d) {
            const s16x4 lo = vtr(vb + d * 64), hi = vtr(vb + 8 * VP + d * 64);
            const bf16x8 vf = __builtin_shufflevector(lo, hi, 0, 1, 2, 3, 4, 5, 6, 7);
            O[d] = MFMA(vf, pf, O[d]);
          }
        }
    }
    if (more) {
      const ldsp wb = lds + ((t + 1) & 1) * ASTG;
      if (SAMPLE) {
#pragma unroll
        for (int i = 0; i < 2; ++i) {
          const u32x4 kk = {pk2(fk[2 * i][0], fk[2 * i][1]), pk2(fk[2 * i][2], fk[2 * i][3]), pk2(fk[2 * i + 1][0], fk[2 * i + 1][1]), pk2(fk[2 * i + 1][2], fk[2 * i + 1][3])};
          const u32x4 vv = {pk2(fv[2 * i][0], fv[2 * i][1]), pk2(fv[2 * i][2], fv[2 * i][3]), pk2(fv[2 * i + 1][0], fv[2 * i + 1][1]), pk2(fv[2 * i + 1][2], fv[2 * i + 1][3])};
          *(LAS u32x4*)(wb + (lrow + 32 * i) * KP + lc * 16) = kk;
          *(LAS u32x4*)(wb + 64 * KP + (lrow + 32 * i) * VP + lc * 16) = vv;
        }
      } else {
#pragma unroll
        for (int i = 0; i < 2; ++i) {
          *(LAS u32x4*)(wb + (lrow + 32 * i) * KP + lc * 16) = sk[i];
          *(LAS u32x4*)(wb + 64 * KP + (lrow + 32 * i) * VP + lc * 16) = sv[i];
        }
      }
    }
    __syncthreads();
  }
  const float lt = l + __shfl_xor(l, 32);
  const float inv = 1.f / lt;
  LAS float* cb = (LAS float*)lds;
  if (j == 1 && active) {
#pragma unroll
    for (int d = 0; d < 4; ++d)
#pragma unroll
      for (int i = 0; i < 16; ++i) cb[(rs * 64 + d * 16 + i) * 64 + lane] = O[d][i] * inv;
  }
  __syncthreads();
  if (j == 0 && active) {
    float ss = 0.f;
#pragma unroll
    for (int d = 0; d < 4; ++d)
#pragma unroll
      for (int i = 0; i < 16; ++i) { const float o = O[d][i] * inv - lam * cb[(rs * 64 + d * 16 + i) * 64 + lane]; O[d][i] = o; ss += o * o; }
    ss += __shfl_xor(ss, 32);
    const float rn = rsqrtf(ss * (1.f / 128.f) + 1e-5f) * 0.8f;
#pragma unroll
    for (int d = 0; d < 4; ++d)
#pragma unroll
      for (int g = 0; g < 4; ++g) {
        const int d0 = d * 32 + 8 * g + 4 * h;
        const f32x4 sg = *(const f32x4*)(p.subln_g + d0);
        const u32x2 ga = *(const u32x2*)(Ga + (size_t)qrow * QP + hd * 128 + d0);
        u32x2 w = {pk2(O[d][4 * g + 0] * rn * sg[0] * bflo(ga[0]), O[d][4 * g + 1] * rn * sg[1] * bfhi(ga[0])),
                   pk2(O[d][4 * g + 2] * rn * sg[2] * bflo(ga[1]), O[d][4 * g + 3] * rn * sg[3] * bfhi(ga[1]))};
        *(u32x2*)(Mix + (size_t)qrow * HP + hd * 128 + d0) = w;
      }
  }
  __syncthreads();
}


constexpr int PSTG = 32768;
DI void attn_prompt(const Params& p, ldsp lds, const int tid, const float lam, const int b, const int hd, const int x) {
  const int wave = __builtin_amdgcn_readfirstlane(tid >> 6), lane = tid & 63, r = lane & 31, h = lane >> 5, rs = wave & 3, j = wave >> 2;
  const bf16_t* Qb = (const bf16_t*)(p.ws + WS_Q);
  const bf16_t* Kb = (const bf16_t*)(p.ws + WS_K);
  const bf16_t* Vb = (const bf16_t*)(p.ws + WS_V);
  const bf16_t* Ga = (const bf16_t*)(p.ws + WS_GA);
  bf16_t* Mix = (bf16_t*)(p.ws + WS_MIX);
  const int nt = 2 * x + 2;
  const int my_nt = 2 * x + 1 + (rs >> 1);
  const int qrow = b * SEQ + x * 128 + 32 * rs + r;
  bf16x8 qf[4];
#pragma unroll
  for (int ks = 0; ks < 4; ++ks) qf[ks] = *(const bf16x8*)(Qb + (size_t)qrow * QP + hd * 128 + j * 64 + ks * 16 + h * 8);
  f32x16 O[4];
#pragma unroll
  for (int d = 0; d < 4; ++d)
#pragma unroll
    for (int i = 0; i < 16; ++i) O[d][i] = 0.f;
  float m = -1e30f, l = 0.f;
  const int lrw = lane >> 4, lcp = lane & 15;
  const int krow0 = wave * 8 + lrw;
  const bf16_t* gk0 = Kb + (size_t)(b * SEQ + krow0) * QP + hd * 128 + ((lcp ^ (krow0 & 15)) * 8);
  const bf16_t* gk1 = Kb + (size_t)(b * SEQ + krow0 + 4) * QP + hd * 128 + ((lcp ^ ((krow0 + 4) & 15)) * 8);
  const bf16_t* gv0 = Vb + (size_t)(b * SEQ + krow0) * QP + hd * 128 + ((lcp ^ ((krow0 & 3) << 2)) * 8);
  const bf16_t* gv1 = Vb + (size_t)(b * SEQ + krow0 + 4) * QP + hd * 128 + ((lcp ^ (((krow0 + 4) & 3) << 2)) * 8);
  const ldsp lk = lds + wave * 2048, lv = lds + 16384 + wave * 2048;
#define ATT_ISSUE(t_) do { const int st_ = ((t_) & 3) * PSTG; const size_t go_ = (size_t)(t_) * 64 * QP; \
    glds16(gk0 + go_, lk + st_); glds16(gk1 + go_, lk + st_ + 1024); glds16(gv0 + go_, lv + st_); glds16(gv1 + go_, lv + st_ + 1024); } while (0)
  ATT_ISSUE(0); ATT_ISSUE(1);
  const int i16 = lane & 15, q4 = i16 >> 2, p4 = i16 & 3, blk = (lane >> 4) & 1;
  const int kswz = r & 15;
  const unsigned vaddr0 = (unsigned)(size_t)(lds + 16384) + (unsigned)((4 * h + q4) * 256 + blk * 32 + p4 * 8);
  const unsigned voff0 = (unsigned)((0 ^ q4) * 64), voff1 = (unsigned)((1 ^ q4) * 64), voff2 = (unsigned)((2 ^ q4) * 64), voff3 = (unsigned)((3 ^ q4) * 64);
  const int np = nt >> 1;
  for (int tp = 0; tp < np; ++tp) {
    wait_vm<0>();
    raw_barrier();
    if (tp + 1 < np) { ATT_ISSUE(2 * tp + 2); ATT_ISSUE(2 * tp + 3); }
#pragma unroll 1
    for (int u = 0; u < 2; ++u) {
    const int t = 2 * tp + u;
    if (t < my_nt) {
      const ldsp Kl = lds + (t & 3) * PSTG, Vl = Kl + 16384;
      f32x16 S[2];
      bf16x8 kf[8];
#pragma unroll
      for (int kb = 0; kb < 2; ++kb)
#pragma unroll
        for (int ks = 0; ks < 4; ++ks) kf[kb * 4 + ks] = *(const LAS bf16x8*)(Kl + (32 * kb + r) * 256 + (((j * 8 + 2 * ks + h) ^ kswz) * 16));
      __builtin_amdgcn_s_setprio(2);
#pragma unroll
      for (int kb = 0; kb < 2; ++kb) {
#pragma unroll
        for (int i = 0; i < 16; ++i) S[kb][i] = 0.f;
#pragma unroll
        for (int ks = 0; ks < 4; ++ks) S[kb] = MFMA(kf[kb * 4 + ks], qf[ks], S[kb]);
      }
      __builtin_amdgcn_s_setprio(0);
      float mx = S[0][0];
#pragma unroll
      for (int i = 1; i < 16; ++i) mx = fmaxf(mx, S[0][i]);
#pragma unroll
      for (int i = 0; i < 16; ++i) mx = fmaxf(mx, S[1][i]);
      mx = fmaxf(mx, __shfl_xor(mx, 32));
      const float mnew = fmaxf(m, mx);
      if (__any(mx > m + 6.f)) {
        const float alpha = __builtin_amdgcn_exp2f(m - mnew);
#pragma unroll
        for (int d = 0; d < 4; ++d)
#pragma unroll
          for (int i = 0; i < 16; ++i) O[d][i] *= alpha;
        l *= alpha; m = mnew;
      }
      float ls = 0.f;
#pragma unroll
      for (int kb = 0; kb < 2; ++kb)
#pragma unroll
        for (int i = 0; i < 16; ++i) { const float pp = __builtin_amdgcn_exp2f(S[kb][i] - m); S[kb][i] = pp; ls += pp; }
      l += ls;
      bf16x8 pfr[4];
#pragma unroll
      for (int kb = 0; kb < 2; ++kb)
#pragma unroll
        for (int s = 0; s < 2; ++s) {
          u32x4 pu = {pk2(S[kb][8 * s + 0], S[kb][8 * s + 1]), pk2(S[kb][8 * s + 2], S[kb][8 * s + 3]), pk2(S[kb][8 * s + 4], S[kb][8 * s + 5]), pk2(S[kb][8 * s + 6], S[kb][8 * s + 7])};
          pfr[kb * 2 + s] = __builtin_bit_cast(bf16x8, pu);
        }
      {
        const unsigned vbase = vaddr0 + (unsigned)((t & 3) * PSTG);
        const unsigned va0 = vbase + voff0, va1 = vbase + voff1, va2 = vbase + voff2, va3 = vbase + voff3;
        s16x4 lo[4], hi[4], lo2[4], hi2[4];
#define TR_ISSUE(L, H, G) do { \
          asm volatile("ds_read_b64_tr_b16 %0, %1 offset:%2" : "=v"(L[0]) : "v"(va0), "n"((G) * 4096)); \
          asm volatile("ds_read_b64_tr_b16 %0, %1 offset:%2" : "=v"(H[0]) : "v"(va0), "n"((G) * 4096 + 2048)); \
          asm volatile("ds_read_b64_tr_b16 %0, %1 offset:%2" : "=v"(L[1]) : "v"(va1), "n"((G) * 4096)); \
          asm volatile("ds_read_b64_tr_b16 %0, %1 offset:%2" : "=v"(H[1]) : "v"(va1), "n"((G) * 4096 + 2048)); \
          asm volatile("ds_read_b64_tr_b16 %0, %1 offset:%2" : "=v"(L[2]) : "v"(va2), "n"((G) * 4096)); \
          asm volatile("ds_read_b64_tr_b16 %0, %1 offset:%2" : "=v"(H[2]) : "v"(va2), "n"((G) * 4096 + 2048)); \
          asm volatile("ds_read_b64_tr_b16 %0, %1 offset:%2" : "=v"(L[3]) : "v"(va3), "n"((G) * 4096)); \
          asm volatile("ds_read_b64_tr_b16 %0, %1 offset:%2" : "=v"(H[3]) : "v"(va3), "n"((G) * 4096 + 2048)); } while (0)
#define TR_WAIT(L, H) asm volatile("s_waitcnt lgkmcnt(0)" : "+v"(L[0]), "+v"(H[0]), "+v"(L[1]), "+v"(H[1]), "+v"(L[2]), "+v"(H[2]), "+v"(L[3]), "+v"(H[3]))
#define TR_MMA(L, H, G) do { __builtin_amdgcn_s_setprio(1); _Pragma("unroll") for (int d = 0; d < 4; ++d) { \
          const bf16x8 vf = __builtin_shufflevector(L[d], H[d], 0, 1, 2, 3, 4, 5, 6, 7); O[d] = MFMA(vf, pfr[G], O[d]); } __builtin_amdgcn_s_setprio(0); } while (0)
        TR_ISSUE(lo, hi, 0);
        TR_WAIT(lo, hi); TR_ISSUE(lo2, hi2, 1); TR_MMA(lo, hi, 0);
        TR_WAIT(lo2, hi2); TR_ISSUE(lo, hi, 2); TR_MMA(lo2, hi2, 1);
        TR_WAIT(lo, hi); TR_ISSUE(lo2, hi2, 3); TR_MMA(lo, hi, 2);
        TR_WAIT(lo2, hi2); TR_MMA(lo2, hi2, 3);
#undef TR_ISSUE
#undef TR_WAIT
#undef TR_MMA
      }
    }
    }
  }
#undef ATT_ISSUE
  raw_barrier();
  const float lt = l + __shfl_xor(l, 32);
  const float inv = 1.f / lt;
  LAS float* cb = (LAS float*)lds;
  if (j == 1) {
#pragma unroll
    for (int d = 0; d < 4; ++d)
#pragma unroll
      for (int i = 0; i < 16; ++i) cb[(rs * 64 + d * 16 + i) * 64 + lane] = O[d][i] * inv;
  }
  __syncthreads();
  if (j == 0) {
    float ss = 0.f;
#pragma unroll
    for (int d = 0; d < 4; ++d)
#pragma unroll
      for (int i = 0; i < 16; ++i) { const float o = O[d][i] * inv - lam * cb[(rs * 64 + d * 16 + i) * 64 + lane]; O[d][i] = o; ss += o * o; }
    ss += __shfl_xor(ss, 32);
    const float rn = rsqrtf(ss * (1.f / 128.f) + 1e-5f) * 0.8f;
#pragma unroll
    for (int d = 0; d < 4; ++d)
#pragma unroll
      for (int g = 0; g < 4; ++g) {
        const int d0 = d * 32 + 8 * g + 4 * h;
        const f32x4 sg = *(const f32x4*)(p.subln_g + d0);
        const u32x2 ga = *(const u32x2*)(Ga + (size_t)qrow * QP + hd * 128 + d0);
        u32x2 w = {pk2(O[d][4 * g + 0] * rn * sg[0] * bflo(ga[0]), O[d][4 * g + 1] * rn * sg[1] * bfhi(ga[0])),
                   pk2(O[d][4 * g + 2] * rn * sg[2] * bflo(ga[1]), O[d][4 * g + 3] * rn * sg[3] * bfhi(ga[1]))};
        *(u32x2*)(Mix + (size_t)qrow * HP + hd * 128 + d0) = w;
      }
  }
  __syncthreads();
}

constexpr int PPITCH = 1040;
DI void pool_unit2(const Params& p, ldsp lds, const int u, const int tid) {
  const int wave = __builtin_amdgcn_readfirstlane(tid >> 6), lane = tid & 63, r = lane & 31, h = lane >> 5;
  const bf16_t* Ub = (const bf16_t*)(p.ws + WS_U);
  const bf16_t* Gp = (const bf16_t*)(p.ws + WS_GP);
  bf16_t* Mix = (bf16_t*)(p.ws + WS_MIX);
  const int R0 = u * 64;
  const bool smp = R0 >= MP;
  const int sl0 = R0 & (SEQ - 1);
#pragma unroll 1
  for (int bt = 0; bt < 1; ++bt) {
    u32x4 vals[12];
#pragma unroll
    for (int i = 0; i < 12; ++i) {
      const int idx = tid + 512 * (bt * 12 + i);
      const int vr = idx >> 6, c = idx & 63;
      const int th = vr >= 47 ? 1 : 0, v = vr - 47 * th;
      u32x4 val = {0u, 0u, 0u, 0u};
      if (idx < 6016) {
        if (!smp) {
          if (sl0 + 32 * th - 15 + v >= 0) val = *(const u32x4*)(Ub + (size_t)(R0 + 32 * th - 15 + v) * QP + c * 8);
        } else {
          const int b = ((R0 - MP) >> 5) + th;
          if (v >= 15) val = *(const u32x4*)(Ub + (size_t)(MP + b * 32 + v - 15) * QP + c * 8);
          else {
            const float* hp = p.state_pool + ((size_t)b * 15 + v) * 512 + c * 8;
            const f32x4 h0 = *(const f32x4*)hp, h1 = *(const f32x4*)(hp + 4);
            val[0] = pk2(h0[0], h0[1]); val[1] = pk2(h0[2], h0[3]); val[2] = pk2(h1[0], h1[1]); val[3] = pk2(h1[2], h1[3]);
          }
        }
      }
      vals[i] = val;
    }
#pragma unroll
    for (int i = 0; i < 12; ++i) {
      const int idx = tid + 512 * (bt * 12 + i);
      if (idx < 6016) *(LAS u32x4*)(lds + (idx >> 6) * PPITCH + (idx & 63) * 16) = vals[i];
    }
  }
  __syncthreads();
  {
    const int g = wave >> 1, th = wave & 1;
    const int W = 2 << g;
    const int s = sl0 + 32 * th + r;
    const float icnt = smp ? (1.f / (float)W) : (1.f / (float)(s + 1 < W ? s + 1 : W));
    const bf16_t* WpT = (const bf16_t*)(p.ws + WS_WPT) + g * 16384;
    f32x16 acc[4];
#pragma unroll
    for (int d = 0; d < 4; ++d)
#pragma unroll
      for (int i = 0; i < 16; ++i) acc[d][i] = 0.f;
    const ldsp rowp = lds + (th * 47 + 15 + r) * PPITCH + (g * 128 + 8 * h) * 2;
#pragma unroll 1
    for (int ks = 0; ks < 8; ++ks) {
      bf16x8 bfr[4];
#pragma unroll
      for (int d = 0; d < 4; ++d) bfr[d] = *(const bf16x8*)(WpT + (size_t)(d * 32 + r) * 128 + 16 * ks + 8 * h);
      const ldsp bp = rowp + ks * 32;
      float sum[8], cur[8];
      {
        const u32x4 uu = *(const LAS u32x4*)bp;
#pragma unroll
        for (int e = 0; e < 4; ++e) { cur[2 * e] = bflo(uu[e]); cur[2 * e + 1] = bfhi(uu[e]); sum[2 * e] = cur[2 * e]; sum[2 * e + 1] = cur[2 * e + 1]; }
      }
#pragma unroll 2
      for (int wi = 1; wi < W; ++wi) {
        const u32x4 uu = *(const LAS u32x4*)(bp - wi * PPITCH);
#pragma unroll
        for (int e = 0; e < 4; ++e) { sum[2 * e] += bflo(uu[e]); sum[2 * e + 1] += bfhi(uu[e]); }
      }
      u32x4 au;
#pragma unroll
      for (int e = 0; e < 4; ++e) au[e] = pk2(sum[2 * e] * icnt - cur[2 * e], sum[2 * e + 1] * icnt - cur[2 * e + 1]);
      const bf16x8 af = __builtin_bit_cast(bf16x8, au);
#pragma unroll
      for (int d = 0; d < 4; ++d) acc[d] = MFMA(af, bfr[d], acc[d]);
    }
#pragma unroll
    for (int d = 0; d < 4; ++d) {
      const int col = g * 128 + d * 32 + r;
      const float sc = p.pool_scale[col];
#pragma unroll
      for (int i = 0; i < 16; ++i)
        *(LAS bf16_t*)(lds + (th * 47 + 15 + crow(i, h)) * PPITCH + col * 2) = (bf16_t)pk2(acc[d][i] * sc, 0.f);
    }
  }
  __syncthreads();
#pragma unroll
  for (int i = 0; i < 8; ++i) {
    const int idx = tid + 512 * i;
    const int row = idx >> 6, c = idx & 63;
    const int th = row >> 5, rr = row & 31;
    const u32x4 a = *(const LAS u32x4*)(lds + (th * 47 + 15 + rr) * PPITCH + c * 16);
    const u32x4 gq = *(const u32x4*)(Gp + (size_t)(R0 + row) * QP + c * 8);
    u32x4 w;
#pragma unroll
    for (int e = 0; e < 4; ++e) w[e] = pk2(bflo(a[e]) * bflo(gq[e]), bfhi(a[e]) * bfhi(gq[e]));
    *(u32x4*)(Mix + (size_t)(R0 + row) * HP + 512 + c * 8) = w;
  }
  __syncthreads();
}

DI void phase2(const Params& p, ldsp lds, const int tid) {
  const int lane = tid & 63;
  const float d1 = wave_sum(p.lq1[lane] * p.lk1[lane]);
  const float d2 = wave_sum(p.lq2[lane] * p.lk2[lane]);
  const float lam = __expf(d1) - __expf(d2) + 0.2f;
  const int q = blockIdx.x & 7;
  unsigned* ctr = (unsigned*)(p.ws + WS_BAR) + p.bar_idx * BAR_REGION_WORDS + 2304 + q * 64;
  volatile LAS int* slot = (volatile LAS int*)(lds + LDS_BYTES - 64);
  for (;;) {
    if (tid == 0) *slot = (int)__hip_atomic_fetch_add(ctr, 1u, __ATOMIC_RELAXED, __HIP_MEMORY_SCOPE_AGENT);
    __syncthreads();
    const int item = *slot;
    __syncthreads();
    if (item >= 114) break;
    int kind, arg;
    if (item < 42) { kind = 0; arg = 63 - item; }
    else if (item < 58) { kind = 1; arg = q + 8 * (item - 42); }
    else if (item < 75) { kind = 0; arg = 79 - item; }
    else if (item < 109) { kind = 2; arg = q + 8 * (item - 75); }
    else { kind = 0; arg = 113 - item; }
    if (!((p.p2mask >> kind) & 1)) continue;
    int tl = tid;
    asm volatile("" : "+v"(tl));
    if (kind == 0) attn_prompt(p, lds, tl, lam, q >> 2, q & 3, arg);
    else if (kind == 1) attn_unit<true>(p, lds, tl, lam, arg >> 2, arg & 3, 0);
    else pool_unit2(p, lds, arg, tl);
  }
}

DI void phase4(const Params& p, const int tid) {
  const int wave = tid >> 6, lane = tid & 63;
  for (int row = blockIdx.x * 8 + wave; row < MT; row += gridDim.x * 16) {
    const int row2 = row + gridDim.x * 8;
    const bool has2 = row2 < MT;
    const bf16_t* yp = (const bf16_t*)(p.ws + WS_YPRE) + (size_t)row * HP;
    const bf16_t* yp2 = (const bf16_t*)(p.ws + WS_YPRE) + (size_t)(has2 ? row2 : row) * HP;
    f32x4 v[4], w4[4]; float ss = 0.f, ss2 = 0.f;
#pragma unroll
    for (int i = 0; i < 4; ++i) {
      const u32x2 a = *(const u32x2*)(yp + lane * 4 + 256 * i), b2 = *(const u32x2*)(yp2 + lane * 4 + 256 * i);
      v[i][0] = bflo(a[0]); v[i][1] = bfhi(a[0]); v[i][2] = bflo(a[1]); v[i][3] = bfhi(a[1]);
      w4[i][0] = bflo(b2[0]); w4[i][1] = bfhi(b2[0]); w4[i][2] = bflo(b2[1]); w4[i][3] = bfhi(b2[1]);
    }
#pragma unroll
    for (int i = 0; i < 4; ++i) {
      ss += v[i][0] * v[i][0] + v[i][1] * v[i][1] + v[i][2] * v[i][2] + v[i][3] * v[i][3];
      ss2 += w4[i][0] * w4[i][0] + w4[i][1] * w4[i][1] + w4[i][2] * w4[i][2] + w4[i][3] * w4[i][3];
    }
    ss = wave_sum(ss); ss2 = wave_sum(ss2);
    const float rs = rsqrtf(ss * (1.f / DM) + 1e-6f), rs2 = rsqrtf(ss2 * (1.f / DM) + 1e-6f);
#pragma unroll
    for (int i = 0; i < 4; ++i) {
      const f32x4 g = *(const f32x4*)(p.final_g + lane * 4 + 256 * i);
      f32x4 w = {v[i][0] * rs * g[0], v[i][1] * rs * g[1], v[i][2] * rs * g[2], v[i][3] * rs * g[3]};
      *(f32x4*)(p.out + O_Y + (size_t)row * DM + lane * 4 + 256 * i) = w;
      if (has2) {
        f32x4 w2 = {w4[i][0] * rs2 * g[0], w4[i][1] * rs2 * g[1], w4[i][2] * rs2 * g[2], w4[i][3] * rs2 * g[3]};
        *(f32x4*)(p.out + O_Y + (size_t)row2 * DM + lane * 4 + 256 * i) = w2;
      }
    }
  }
}

DI unsigned xcc_id() { return (unsigned)__builtin_amdgcn_s_getreg((3 << 11) | 20) & 0xFu; }
DI unsigned ld_rlx(unsigned* p) { return __hip_atomic_load(p, __ATOMIC_RELAXED, __HIP_MEMORY_SCOPE_AGENT); }
DI unsigned add_rlx(unsigned* p, unsigned v) { return __hip_atomic_fetch_add(p, v, __ATOMIC_RELAXED, __HIP_MEMORY_SCOPE_AGENT); }
DI void gridbar_post(unsigned* base, ldsp lds, const int tid) {
  if (tid == 0) {
    volatile LAS unsigned* st = (volatile LAS unsigned*)(lds + LDS_BYTES - 64);
    const unsigned xcc = xcc_id();
    add_rlx(base + 64 + 64 * xcc, 1u);
    add_rlx(base, 1u);
    st[4] = xcc; st[7] = 0u;
  }
}
DI void gridbar_complete(unsigned* base, ldsp lds, const int tid) {
  if (tid == 0) {
    volatile LAS unsigned* st = (volatile LAS unsigned*)(lds + LDS_BYTES - 64);
    while (ld_rlx(base) < gridDim.x) __builtin_amdgcn_s_sleep(4);
    unsigned nx = 0;
    for (int x = 0; x < 16; ++x) nx += (ld_rlx(base + 64 + 64 * x) != 0u) ? 1u : 0u;
    st[5] = ld_rlx(base + 64 + 64 * st[4]); st[6] = nx;
  }
}
DI void grid_barrier(unsigned* base, ldsp lds, const int tid) {
  asm volatile("s_waitcnt vmcnt(0)" ::: "memory");
  __syncthreads();
  if (tid == 0) {
    volatile LAS unsigned* st = (volatile LAS unsigned*)(lds + LDS_BYTES - 64);
    const unsigned xcc = st[4], nloc = st[5], nx = st[6], k = st[7] + 1u;
    st[7] = k;
    const unsigned old = add_rlx(base + 1152 + 64 * xcc, 1u);
    if (old + 1u == nloc * k) {
      __builtin_amdgcn_fence(__ATOMIC_RELEASE, "agent");
      add_rlx(base + 2240, 1u);
    }
    while (ld_rlx(base + 2240) < nx * k) __builtin_amdgcn_s_sleep(4);
    __builtin_amdgcn_fence(__ATOMIC_ACQUIRE, "agent");
  }
  __syncthreads();
}

__global__ void __launch_bounds__(512) mega(Params p) {
  extern __shared__ __attribute__((aligned(16))) unsigned char lds_raw[];
  const ldsp lds = (ldsp)lds_raw;
  const int tid = threadIdx.x;
  cg::grid_group grid = cg::this_grid();
  const int lo = p.ph_lo, hi = p.ph_hi;
#ifndef PHMASK
#define PHMASK 31
#endif
  if ((PHMASK & 1) && lo <= 0 && 0 < hi) phase0(p, lds, tid);
  unsigned* const gbase = (unsigned*)(p.ws + WS_BAR) + p.bar_idx * BAR_REGION_WORDS;
  gridbar_post(gbase, lds, tid);
  bool gb_ready = false;
#define GRID_BARRIER() do { if (!gb_ready) { gridbar_complete(gbase, lds, tid); gb_ready = true; } grid_barrier(gbase, lds, tid); } while (0)
  if (lo < -1000) grid.sync();
  if (lo <= 0 && 1 < hi) GRID_BARRIER();
  if ((PHMASK & 2) && lo <= 1 && 1 < hi) {
    EpiIn e{(const float*)(p.ws + WS_ROPE), p.out, p.ws};
    gemm_glds<64, 2, 5, EpiIn, true>((const bf16_t*)(p.ws + WS_HB), (const bf16_t*)(p.ws + WS_WINT), MP, MS, NIN, DM, lds, tid, e, p.mode);
    gemm_glds<256, 4, 4>((const bf16_t*)(p.ws + WS_HB), (const bf16_t*)(p.ws + WS_WINT), 0, MP, NIN, DM, lds, tid, e, p.mode);
  }
  if (lo <= 1 && 2 < hi) GRID_BARRIER();
  if ((PHMASK & 4) && lo <= 2 && 2 < hi) phase2(p, lds, tid);
  if (lo <= 2 && 3 < hi) GRID_BARRIER();
  if ((PHMASK & 8) && lo <= 3 && 3 < hi) {
    EpiOut e{p.x_prompt, p.x_sample, (bf16_t*)(p.ws + WS_YPRE)};
    gemm_glds<128, 2, 5>((const bf16_t*)(p.ws + WS_MIX), (const bf16_t*)(p.ws + WS_WOUTT), 0, MP, DM, DM, lds, tid, e, p.mode);
    gemm_glds<64, 2, 5>((const bf16_t*)(p.ws + WS_MIX), (const bf16_t*)(p.ws + WS_WOUTT), MP, MS, DM, DM, lds, tid, e, p.mode);
  }
  if (lo <= 3 && 4 < hi) GRID_BARRIER();
  if ((PHMASK & 16) && lo <= 4 && 4 < hi) phase4(p, tid);
}

extern "C" void kernel_launch(void* const* d_in, const int* in_sizes, int n_in, void* d_out, int out_size, void* d_ws, size_t ws_size, hipStream_t stream) {
  static int grid_blocks = 0;
  if (!grid_blocks) {
    int dev = 0, cus = 0, per_cu = 0;
    hipGetDevice(&dev);
    hipDeviceGetAttribute(&cus, hipDeviceAttributeMultiprocessorCount, dev);
    if (hipFuncSetAttribute((const void*)mega, hipFuncAttributeMaxDynamicSharedMemorySize, LDS_BYTES) != hipSuccess) fprintf(stderr, "hipFuncSetAttribute failed\n");
    if (hipOccupancyMaxActiveBlocksPerMultiprocessor(&per_cu, (const void*)mega, 512, LDS_BYTES) != hipSuccess || per_cu < 1) { fprintf(stderr, "occupancy query gave %d\n", per_cu); per_cu = 1; }
    (void)hipGetLastError();
    if (cus <= 0) cus = 256;
    grid_blocks = cus * per_cu;
  }
  Params p{};
  p.x_prompt = (const float*)d_in[0]; p.x_sample = (const float*)d_in[1]; p.cache_k = (const float*)d_in[2]; p.cache_v = (const float*)d_in[3];
  p.state_pool = (const float*)d_in[4]; p.norm_g = (const float*)d_in[5]; p.w_in = (const float*)d_in[6];
  p.lq1 = (const float*)d_in[7]; p.lk1 = (const float*)d_in[8]; p.lq2 = (const float*)d_in[9]; p.lk2 = (const float*)d_in[10];
  p.subln_g = (const float*)d_in[11]; p.w_pool = (const float*)d_in[12]; p.pool_scale = (const float*)d_in[13]; p.w_out = (const float*)d_in[14]; p.final_g = (const float*)d_in[15];
  p.out = (float*)d_out; p.ws = (unsigned char*)d_ws; p.p2mask = 7;
  (void)hipMemsetAsync((unsigned char*)d_ws + WS_BAR, 0, 2 * BAR_REGION_WORDS * 4, stream);
#if NLAUNCH == 1
#ifndef PROBE_K
  p.ph_lo = 0; p.ph_hi = 5;
  void* args[] = {&p};
  hipError_t e = hipLaunchCooperativeKernel((const void*)mega, dim3(grid_blocks), dim3(512), args, LDS_BYTES, stream);
  if (e != hipSuccess) fprintf(stderr, "cooperative launch failed: %s (grid %d)\n", hipGetErrorString(e), grid_blocks);
#else
  Params p2 = p;
  p.ph_lo = 0; p.ph_hi = PROBE_K + 1; p2.ph_lo = PROBE_K; p2.ph_hi = 5; p2.bar_idx = 1;
#ifdef PROBE_MASK
  p2.p2mask = PROBE_MASK;
#endif
#ifdef PROBE_MODE
  p2.mode = PROBE_MODE; p2.ph_hi = PROBE_K + 1; p.ph_hi = 5;
#endif
  void* args[] = {&p};
  void* args2[] = {&p2};
  hipError_t e = hipLaunchCooperativeKernel((const void*)mega, dim3(grid_blocks), dim3(512), args, LDS_BYTES, stream);
  if (e == hipSuccess) e = hipLaunchCooperativeKernel((const void*)mega, dim3(grid_blocks), dim3(512), args2, LDS_BYTES, stream);
  if (e != hipSuccess) fprintf(stderr, "cooperative launch failed: %s (grid %d)\n", hipGetErrorString(e), grid_blocks);
#endif
#else
  for (int ph = 0; ph < 5; ++ph) {
    p.ph_lo = ph; p.ph_hi = ph + 1;
    hipLaunchKernelGGL(mega, dim3(grid_blocks), dim3(512), LDS_BYTES, stream, p);
  }
#endif
}
```

```cpp
#include <hip/hip_runtime.h>
#include <hip/hip_cooperative_groups.h>
#include <cstdio>
namespace cg = cooperative_groups;

#ifndef NLAUNCH
#define NLAUNCH 1
#endif

#define LAS __attribute__((address_space(3)))
#define DI __device__ __forceinline__
typedef __attribute__((ext_vector_type(8))) short bf16x8;
typedef __attribute__((ext_vector_type(4))) short s16x4;
typedef __attribute__((ext_vector_type(16))) float f32x16;
typedef __attribute__((ext_vector_type(4))) float f32x4;
typedef __attribute__((ext_vector_type(2))) float f32x2;
typedef __attribute__((ext_vector_type(4))) unsigned u32x4;
typedef __attribute__((ext_vector_type(2))) unsigned u32x2;
typedef __attribute__((ext_vector_type(2))) __bf16 bf16x2_t;
typedef unsigned short bf16_t;
typedef LAS unsigned char* ldsp;

#define MFMA(a, b, c) __builtin_amdgcn_mfma_f32_32x32x16_bf16((a), (b), (c), 0, 0, 0)

constexpr int DM = 1024, SEQ = 8192, MP = 16384, MS = 1024, MT = MP + MS, NIN = 3072;
constexpr size_t MiB = 1u << 20;
constexpr int HP = 1088, QP = 576;
constexpr size_t WS_WINT = 0, WS_WOUTT = 8 * MiB, WS_WPT = 11 * MiB, WS_ROPE = 12 * MiB, WS_HB = 16 * MiB;
constexpr size_t WS_Q = 56 * MiB, WS_SEG = 20 * MiB;
constexpr size_t WS_K = WS_Q + WS_SEG, WS_V = WS_Q + 2 * WS_SEG, WS_GA = WS_Q + 3 * WS_SEG, WS_U = WS_Q + 4 * WS_SEG, WS_GP = WS_Q + 5 * WS_SEG;
constexpr size_t WS_MIX = 176 * MiB;
constexpr size_t WS_BAR = 255 * MiB;
constexpr int BAR_REGION_WORDS = 4096;
constexpr size_t WS_YPRE = 256 * MiB;
constexpr size_t O_Y = 0, O_KP = 17825792, O_VP = 26214400, O_PP = 34603008, O_KS = 34618368, O_VS = 35142656, O_PS = 35666944;
constexpr float QSCALE = 0.125f * 1.4426950408889634f;
constexpr int LDS_BYTES = 147456;

struct Params {
  const float *x_prompt, *x_sample, *cache_k, *cache_v, *state_pool, *norm_g, *w_in, *lq1, *lk1, *lq2, *lk2, *subln_g, *w_pool, *pool_scale, *w_out, *final_g;
  float* out; unsigned char* ws; int ph_lo, ph_hi, bar_idx, p2mask, mode, pad;
};

DI unsigned pk2(float lo, float hi) { f32x2 v = {lo, hi}; bf16x2_t b = __builtin_convertvector(v, bf16x2_t); return __builtin_bit_cast(unsigned, b); }
DI float bflo(unsigned u) { return __uint_as_float(u << 16); }
DI float bfhi(unsigned u) { return __uint_as_float(u & 0xffff0000u); }
DI float wave_sum(float v) {
#pragma unroll
  for (int o = 32; o; o >>= 1) v += __shfl_xor(v, o);
  return v;
}
DI int crow(int i, int h) { return (i & 3) + 8 * (i >> 2) + 4 * h; }
DI float silu(float v) { return v * __builtin_amdgcn_rcpf(1.f + __builtin_amdgcn_exp2f(-1.4426950408889634f * v)); }
DI int row_pos(int row) { return row < MP ? (row & (SEQ - 1)) : 2048 + ((row - MP) & 31); }
DI const float* x_row(const Params& p, int row) { return row < MP ? p.x_prompt + (size_t)row * DM : p.x_sample + (size_t)(row - MP) * DM; }

DI void phase0(const Params& p, ldsp lds, const int tid) {
  const int wave = tid >> 6, lane = tid & 63;
  const int G = gridDim.x, bid = blockIdx.x;
  bf16_t* WinT = (bf16_t*)(p.ws + WS_WINT);
  bf16_t* WoutT = (bf16_t*)(p.ws + WS_WOUTT);
  bf16_t* WpT = (bf16_t*)(p.ws + WS_WPT);
  for (int it = bid * 8 + wave; it < 1040 * 8; it += G * 8) {
    const int t = it >> 3, sub = it & 7;
    const float* W; bf16_t* WT; int ldw, ldt, k0, n0;
    if (t < 768) { W = p.w_in; WT = WinT; ldw = NIN; ldt = HP; k0 = (t / 48) * 64; n0 = (t % 48) * 64; }
    else if (t < 1024) { const int u = t - 768; W = p.w_out; WT = WoutT; ldw = DM; ldt = HP; k0 = (u >> 4) * 64; n0 = (u & 15) * 64; }
    else { const int u = t - 1024; const int g = u >> 2; W = p.w_pool + g * 16384; WT = WpT + g * 16384; ldw = 128; ldt = 128; k0 = ((u >> 1) & 1) * 64; n0 = (u & 1) * 64; }
    const float* src = W + (size_t)(k0 + lane) * ldw + n0 + sub * 8;
    const f32x4 a0 = *(const f32x4*)src, a1 = *(const f32x4*)(src + 4);
    bf16_t* dstp = WT + (size_t)(n0 + sub * 8) * ldt + k0 + lane;
    dstp[0 * (size_t)ldt] = (bf16_t)pk2(a0[0], 0.f); dstp[1 * (size_t)ldt] = (bf16_t)pk2(a0[1], 0.f);
    dstp[2 * (size_t)ldt] = (bf16_t)pk2(a0[2], 0.f); dstp[3 * (size_t)ldt] = (bf16_t)pk2(a0[3], 0.f);
    dstp[4 * (size_t)ldt] = (bf16_t)pk2(a1[0], 0.f); dstp[5 * (size_t)ldt] = (bf16_t)pk2(a1[1], 0.f);
    dstp[6 * (size_t)ldt] = (bf16_t)pk2(a1[2], 0.f); dstp[7 * (size_t)ldt] = (bf16_t)pk2(a1[3], 0.f);
  }
  {
    bf16_t* Hb = (bf16_t*)(p.ws + WS_HB);
    for (int row = bid * 8 + wave; row < MT; row += G * 32) {
      f32x4 v[4][4]; float ss[4];
#pragma unroll
      for (int q = 0; q < 4; ++q) {
        const int rw = row + q * G * 8;
        const float* x = x_row(p, rw < MT ? rw : row);
#pragma unroll
        for (int i = 0; i < 4; ++i) v[q][i] = *(const f32x4*)(x + lane * 4 + 256 * i);
      }
#pragma unroll
      for (int q = 0; q < 4; ++q) {
        float a = 0.f;
#pragma unroll
        for (int i = 0; i < 4; ++i) a += v[q][i][0] * v[q][i][0] + v[q][i][1] * v[q][i][1] + v[q][i][2] * v[q][i][2] + v[q][i][3] * v[q][i][3];
        ss[q] = rsqrtf(wave_sum(a) * (1.f / DM) + 1e-6f);
      }
#pragma unroll
      for (int i = 0; i < 4; ++i) {
        const f32x4 g = *(const f32x4*)(p.norm_g + lane * 4 + 256 * i);
#pragma unroll
        for (int q = 0; q < 4; ++q) {
          const int rw = row + q * G * 8;
          if (rw < MT) {
            const float rs = ss[q];
            u32x2 w = {pk2(v[q][i][0] * rs * g[0], v[q][i][1] * rs * g[1]), pk2(v[q][i][2] * rs * g[2], v[q][i][3] * rs * g[3])};
            *(u32x2*)(Hb + (size_t)rw * HP + lane * 4 + 256 * i) = w;
          }
        }
      }
    }
  }
}

constexpr int BK = 64, LDP = 144;

template <int BM, int WGM, class Epi>
DI void gemm_phase(const bf16_t* __restrict__ A, const bf16_t* __restrict__ Bt, const int Mrows, const int N, const int K, ldsp lds, const int tid, const Epi& epi) {
  constexpr int BN = 256, A_BYTES = BM * LDP, STAGE = (BM + BN) * LDP, NA = BM / 64, WROWS = BM / WGM, WCOLS = BN / (8 / WGM), TM = WROWS / 32, TN = WCOLS / 32;
  const int wave = tid >> 6, lane = tid & 63, r = lane & 31, h = lane >> 5, wm = wave % WGM, wn = wave / WGM;
  const int tiles_n = N / BN, ntiles = (Mrows / BM) * tiles_n, nk = K / BK;
  const int lrow = tid >> 3, lc = tid & 7;
  for (int t = blockIdx.x; t < ntiles; t += gridDim.x) {
    const int m0 = (t / tiles_n) * BM, n0 = (t % tiles_n) * BN;
    const bf16_t* ag = A + (size_t)(m0 + lrow) * K + lc * 8;
    const bf16_t* bg = Bt + (size_t)(n0 + lrow) * K + lc * 8;
    u32x4 ra[NA], rb[4];
    f32x16 acc[TM][TN];
#pragma unroll
    for (int a = 0; a < TM; ++a)
#pragma unroll
      for (int b = 0; b < TN; ++b)
#pragma unroll
        for (int i = 0; i < 16; ++i) acc[a][b][i] = 0.f;
#pragma unroll
    for (int i = 0; i < NA; ++i) ra[i] = *(const u32x4*)(ag + (size_t)i * 64 * K);
#pragma unroll
    for (int i = 0; i < 4; ++i) rb[i] = *(const u32x4*)(bg + (size_t)i * 64 * K);
#pragma unroll
    for (int i = 0; i < NA; ++i) *(LAS u32x4*)(lds + (lrow + 64 * i) * LDP + lc * 16) = ra[i];
#pragma unroll
    for (int i = 0; i < 4; ++i) *(LAS u32x4*)(lds + A_BYTES + (lrow + 64 * i) * LDP + lc * 16) = rb[i];
    __syncthreads();
    for (int kt = 0; kt < nk; ++kt) {
      const bool more = kt + 1 < nk;
      if (more) {
#pragma unroll
        for (int i = 0; i < NA; ++i) ra[i] = *(const u32x4*)(ag + (size_t)i * 64 * K + (kt + 1) * BK);
#pragma unroll
        for (int i = 0; i < 4; ++i) rb[i] = *(const u32x4*)(bg + (size_t)i * 64 * K + (kt + 1) * BK);
      }
      const ldsp sa = lds + (kt & 1) * STAGE + (wm * WROWS + r) * LDP + h * 16;
      const ldsp sb = lds + (kt & 1) * STAGE + A_BYTES + (wn * WCOLS + r) * LDP + h * 16;
#pragma unroll
      for (int ks = 0; ks < 4; ++ks) {
        bf16x8 af[TM], bfr[TN];
#pragma unroll
        for (int a = 0; a < TM; ++a) af[a] = *(const LAS bf16x8*)(sa + a * 32 * LDP + ks * 32);
#pragma unroll
        for (int b = 0; b < TN; ++b) bfr[b] = *(const LAS bf16x8*)(sb + b * 32 * LDP + ks * 32);
#pragma unroll
        for (int a = 0; a < TM; ++a)
#pragma unroll
          for (int b = 0; b < TN; ++b) acc[a][b] = MFMA(af[a], bfr[b], acc[a][b]);
      }
      if (more) {
        const ldsp wbase = lds + ((kt + 1) & 1) * STAGE;
#pragma unroll
        for (int i = 0; i < NA; ++i) *(LAS u32x4*)(wbase + (lrow + 64 * i) * LDP + lc * 16) = ra[i];
#pragma unroll
        for (int i = 0; i < 4; ++i) *(LAS u32x4*)(wbase + A_BYTES + (lrow + 64 * i) * LDP + lc * 16) = rb[i];
      }
      __syncthreads();
    }
#pragma unroll
    for (int a = 0; a < TM; ++a)
#pragma unroll
      for (int b = 0; b < TN; ++b) epi(acc[a][b], m0 + wm * WROWS + a * 32, n0 + wn * WCOLS + b * 32, r, h);
  }
}


#define GAS __attribute__((address_space(1)))
DI void glds16(const void* g, ldsp l) { __builtin_amdgcn_global_load_lds((const GAS unsigned*)g, (LAS unsigned*)l, 16, 0, 0); }
template <int N> DI void wait_vm() { asm volatile("s_waitcnt vmcnt(%0)" ::"n"(N) : "memory"); }
DI void raw_barrier() { asm volatile("s_waitcnt lgkmcnt(0)" ::: "memory"); __builtin_amdgcn_s_barrier(); }

template <int PER, int MAXS> DI void wait_stages(const int rem) {
  if (rem >= MAXS) wait_vm<MAXS * PER>();
  else if constexpr (MAXS > 0) wait_stages<PER, MAXS - 1>(rem);
}

template <int BM, int WGM, int NS, class Epi, bool REV = false>
DI void gemm_glds(const bf16_t* __restrict__ A, const bf16_t* __restrict__ Bt, const int row0, const int Mrows, const int N, const int K, ldsp lds, const int tid, const Epi& epi, const int mode) {
  constexpr int BN = 256, A_BYTES = BM * 64, STAGE = (BM + BN) * 64;
  static_assert(NS * STAGE <= LDS_BYTES - 64, "LDS ring too large");
  constexpr int WGN = 8 / WGM, WROWS = BM / WGM, WCOLS = BN / WGN, TM = WROWS / 32, TN = WCOLS / 32, NAI = (BM >= 128) ? BM / 128 : 1, AW = (BM >= 128) ? 8 : BM / 16, PER = NAI + 2;
  const int wave = __builtin_amdgcn_readfirstlane(tid >> 6), lane = tid & 63, r = lane & 31, h = lane >> 5, wm = wave % WGM, wn = wave / WGM;
  const int tiles_n = N / BN, ntiles = (Mrows / BM) * tiles_n, nk = K / 32;
  const int lr = lane >> 2, lchunk = (lane & 3) ^ ((lr >> 2) & 3);
  const int swz = (r >> 2) & 3;
  for (int t = REV ? (int)(gridDim.x - 1 - blockIdx.x) : (int)blockIdx.x; t < ntiles; t += gridDim.x) {
    const int m0 = row0 + (t / tiles_n) * BM, n0 = (t % tiles_n) * BN;
    const bf16_t* ga = A + (size_t)(m0 + (wave % AW) * NAI * 16 + lr) * HP + lchunk * 8;
    const bf16_t* gb = Bt + (size_t)(n0 + wave * 32 + lr) * HP + lchunk * 8;
    const ldsp la = lds + (wave % AW) * NAI * 1024, lb = lds + A_BYTES + wave * 2048;
    f32x16 acc[TM][TN];
#pragma unroll
    for (int a = 0; a < TM; ++a)
#pragma unroll
      for (int b = 0; b < TN; ++b)
#pragma unroll
        for (int i = 0; i < 16; ++i) acc[a][b][i] = 0.f;
#define GEMM_ISSUE(kt_, slot_) do { const int st_ = (slot_) * STAGE; \
      _Pragma("unroll") for (int i_ = 0; i_ < NAI; ++i_) glds16(ga + (size_t)i_ * 16 * HP + (kt_) * 32, la + st_ + i_ * 1024); \
      _Pragma("unroll") for (int i_ = 0; i_ < 2; ++i_) glds16(gb + (size_t)i_ * 16 * HP + (kt_) * 32, lb + st_ + i_ * 1024); } while (0)
#pragma unroll
    for (int i = 0; i < NS - 1; ++i) GEMM_ISSUE(i, i);
    int rs_ = 0, ws_ = NS - 1;
    for (int kt = 0; kt < nk; ++kt) {
      wait_stages<PER, NS - 2>(nk - 1 - kt);
      raw_barrier();
      if (kt + NS - 1 < nk) GEMM_ISSUE(kt + NS - 1, ws_);
      const ldsp sa = lds + rs_ * STAGE + (wm * WROWS + r) * 64;
      const ldsp sb = lds + rs_ * STAGE + A_BYTES + (wn * WCOLS + r) * 64;
      rs_ = (rs_ + 1 == NS) ? 0 : rs_ + 1; ws_ = (ws_ + 1 == NS) ? 0 : ws_ + 1;
#pragma unroll
      for (int ks = 0; ks < 2; ++ks) {
        const int co = ((ks * 2 + h) ^ swz) * 16;
        bf16x8 af[TM], bfr[TN];
#pragma unroll
        for (int a = 0; a < TM; ++a) af[a] = *(const LAS bf16x8*)(sa + a * 2048 + co);
#pragma unroll
        for (int b = 0; b < TN; ++b) bfr[b] = *(const LAS bf16x8*)(sb + b * 2048 + co);
#pragma unroll
        for (int a = 0; a < TM; ++a)
#pragma unroll
          for (int b = 0; b < TN; ++b) acc[a][b] = MFMA(af[a], bfr[b], acc[a][b]);
      }
    }
#undef GEMM_ISSUE
    if constexpr (Epi::KIND == 1) {
      raw_barrier();
#pragma unroll
      for (int a = 0; a < TM; ++a) epi.template rowblock<TN>(acc[a], m0 + wm * WROWS + a * 32, n0 + wn * WCOLS, lane, lds + wave * 16896);
    } else {
      static_assert(TN == 2, "64-column wave-tile epilogue");
      raw_barrier();
      epi.template tile64<TM>(acc, m0 + wm * WROWS, n0 + wn * WCOLS, lane, lds + wave * 17408);
    }
    raw_barrier();
  }
}

struct EpiIn {
  static constexpr int KIND = 1;
  const float* rope; float* out; unsigned char* ws;
  template <int TN>
  DI void rowblock(const f32x16* acc, const int mb, const int nb0, const int lane, ldsp wl) const {
    constexpr int SP = TN * 32 + 4, LPR = TN * 2, RPP = 64 / LPR, NP = 32 / RPP;
    const int r = lane & 31, h = lane >> 5;
    LAS float* st = (LAS float*)wl;
#pragma unroll
    for (int b = 0; b < TN; ++b)
#pragma unroll
      for (int i = 0; i < 16; ++i) st[crow(i, h) * SP + b * 32 + r] = acc[b][i];
    const int seg = nb0 >> 9, c0 = nb0 & 511;
    bf16_t* dst = (bf16_t*)(ws + WS_Q + (size_t)seg * WS_SEG);
    const int cg = lane % LPR, col_l = cg * 16;
#pragma unroll 2
    for (int pass = 0; pass < NP; ++pass) {
      const int row_l = pass * RPP + (lane / LPR);
      const int row = mb + row_l, c = c0 + col_l;
      f32x4 v[4];
#pragma unroll
      for (int k = 0; k < 4; ++k) v[k] = *(const LAS f32x4*)(st + row_l * SP + col_l + 4 * k);
      if (seg < 2 && (col_l & 63) == 0) {
        const float fpos = (float)row_pos(row);
        const float rc[8] = {0.15915494309189535f, 0.03086376340470123f, 0.005985185712713705f, 0.001160663641240061f, 0.00022507907903927653f, 4.364795279280289e-05f, 8.464330808241401e-06f, 1.6414262627950345e-06f};
        float cs[16];
#pragma unroll
        for (int i = 0; i < 8; ++i) { const float fr = __builtin_amdgcn_fractf(fpos * rc[i]); cs[2 * i] = __builtin_amdgcn_cosf(fr); cs[2 * i + 1] = __builtin_amdgcn_sinf(fr); }
#pragma unroll
        for (int i = 0; i < 8; ++i) {
          const float a = v[i >> 2][i & 3], bb = v[2 + (i >> 2)][i & 3];
          v[i >> 2][i & 3] = a * cs[2 * i] - bb * cs[2 * i + 1];
          v[2 + (i >> 2)][i & 3] = bb * cs[2 * i] + a * cs[2 * i + 1];
        }
      }
      if (seg == 0) {
#pragma unroll
        for (int k = 0; k < 4; ++k) v[k] *= QSCALE;
      } else if (seg == 1 || seg == 2) {
        float* o = (row < MP) ? out + (seg == 1 ? O_KP : O_VP) + (size_t)row * 512 + c : out + (seg == 1 ? O_KS : O_VS) + (size_t)(row - MP) * 512 + c;
#pragma unroll
        for (int k = 0; k < 4; ++k) *(f32x4*)(o + 4 * k) = v[k];
      } else if (seg == 3 || seg == 5) {
#pragma unroll
        for (int k = 0; k < 4; ++k)
#pragma unroll
          for (int e = 0; e < 4; ++e) v[k][e] = silu(v[k][e]);
      } else {
        float* o = nullptr;
        if (row < MP) { const int s = row & (SEQ - 1); if (s >= SEQ - 15) o = out + O_PP + ((size_t)(row >> 13) * 15 + (s - (SEQ - 15))) * 512 + c; }
        else { const int s = (row - MP) & 31; if (s >= 17) o = out + O_PS + ((size_t)((row - MP) >> 5) * 15 + (s - 17)) * 512 + c; }
        if (o) {
#pragma unroll
          for (int k = 0; k < 4; ++k) *(f32x4*)(o + 4 * k) = v[k];
        }
      }
      const u32x4 w0 = {pk2(v[0][0], v[0][1]), pk2(v[0][2], v[0][3]), pk2(v[1][0], v[1][1]), pk2(v[1][2], v[1][3])};
      const u32x4 w1 = {pk2(v[2][0], v[2][1]), pk2(v[2][2], v[2][3]), pk2(v[3][0], v[3][1]), pk2(v[3][2], v[3][3])};
      *(u32x4*)(dst + (size_t)row * QP + c) = w0;
      *(u32x4*)(dst + (size_t)row * QP + c + 8) = w1;
    }
  }
  DI void operator()(const f32x16& acc, const int mb, const int nb, const int r, const int h) const {
    const int seg = nb >> 9;
    const int c = (nb & 511) + r;
    bf16_t* dst = (bf16_t*)(ws + WS_Q + (size_t)seg * WS_SEG);
    const bool do_rope = (seg < 2) && ((nb & 63) == 0);
#pragma unroll
    for (int i = 0; i < 16; ++i) {
      const int row = mb + crow(i, h);
      float v = acc[i];
      if (do_rope) {
        const float pv = __shfl_xor(v, 8);
        if (r < 16) {
          const f32x2 cs = *(const f32x2*)(rope + ((size_t)row_pos(row) * 8 + (r & 7)) * 2);
          v = (r < 8) ? (v * cs[0] - pv * cs[1]) : (v * cs[0] + pv * cs[1]);
        }
      }
      if (seg == 0) {
        dst[(size_t)row * QP + c] = (bf16_t)pk2(v * QSCALE, 0.f);
      } else if (seg == 1 || seg == 2) {
        float* o = (row < MP) ? out + (seg == 1 ? O_KP : O_VP) + (size_t)row * 512 + c : out + (seg == 1 ? O_KS : O_VS) + (size_t)(row - MP) * 512 + c;
        *o = v;
        dst[(size_t)row * QP + c] = (bf16_t)pk2(v, 0.f);
      } else if (seg == 3 || seg == 5) {
        dst[(size_t)row * QP + c] = (bf16_t)pk2(silu(v), 0.f);
      } else {
        dst[(size_t)row * QP + c] = (bf16_t)pk2(v, 0.f);
        if (row < MP) {
          const int s = row & (SEQ - 1);
          if (s >= SEQ - 15) out[O_PP + ((size_t)(row >> 13) * 15 + (s - (SEQ - 15))) * 512 + c] = v;
        } else {
          const int s = (row - MP) & 31;
          if (s >= 17) out[O_PS + ((size_t)((row - MP) >> 5) * 15 + (s - 17)) * 512 + c] = v;
        }
      }
    }
  }
};

struct EpiOut {
  static constexpr int KIND = 2;
  const float* xp; const float* xs; bf16_t* out;
  template <int TM>
  DI void tile64(const f32x16 (&acc)[TM][2], const int mb, const int nb, const int lane, ldsp wl) const {
    const int r = lane & 31, h = lane >> 5;
    LAS float* st = (LAS float*)wl;
    const int rq = lane >> 4, c4 = (lane & 15) * 4;
    f32x4 xv[TM * 8];
#pragma unroll
    for (int ps = 0; ps < TM * 8; ++ps) {
      const int row = mb + ps * 4 + rq;
      const float* x = row < MP ? xp + (size_t)row * DM : xs + (size_t)(row - MP) * DM;
      xv[ps] = *(const f32x4*)(x + nb + c4);
    }
#pragma unroll
    for (int a = 0; a < TM; ++a)
#pragma unroll
      for (int b = 0; b < 2; ++b)
#pragma unroll
        for (int i = 0; i < 16; ++i) st[(a * 32 + crow(i, h)) * 68 + b * 32 + r] = acc[a][b][i];
#pragma unroll
    for (int ps = 0; ps < TM * 8; ++ps) {
      const int row = mb + ps * 4 + rq;
      const f32x4 v = *(const LAS f32x4*)(st + (ps * 4 + rq) * 68 + c4);
      const f32x4 y4 = v + xv[ps];
      const u32x2 yb = {pk2(y4[0], y4[1]), pk2(y4[2], y4[3])};
      *(u32x2*)(out + (size_t)row * HP + nb + c4) = yb;
    }
  }
};

constexpr int KP = 272, VP = 320, ASTG = 64 * KP + 64 * VP;

DI s16x4 vtr(ldsp p) { return __builtin_bit_cast(s16x4, __builtin_amdgcn_ds_read_tr16_b64_v4i16((LAS s16x4*)p)); }

template <bool SAMPLE>
DI void attn_unit(const Params& p, ldsp lds, const int tid, const float lam, const int b, const int hd, const int x) {
  const int wave = tid >> 6, lane = tid & 63, r = lane & 31, h = lane >> 5, rs = wave & 3, j = wave >> 2;
  const bf16_t* Qb = (const bf16_t*)(p.ws + WS_Q);
  const bf16_t* Kb = (const bf16_t*)(p.ws + WS_K);
  const bf16_t* Vb = (const bf16_t*)(p.ws + WS_V);
  const bf16_t* Ga = (const bf16_t*)(p.ws + WS_GA);
  bf16_t* Mix = (bf16_t*)(p.ws + WS_MIX);
  const int nt = SAMPLE ? 33 : 2 * x + 2;
  const int my_nt = SAMPLE ? 33 : 2 * x + 1 + (rs >> 1);
  const bool active = SAMPLE ? (rs == 0) : true;
  const int row0 = SAMPLE ? MP + b * 32 : b * SEQ + x * 128;
  const int qrow = row0 + (SAMPLE ? 0 : 32 * rs) + r;
  bf16x8 qf[4];
#pragma unroll
  for (int ks = 0; ks < 4; ++ks) qf[ks] = *(const bf16x8*)(Qb + (size_t)qrow * QP + hd * 128 + j * 64 + ks * 16 + h * 8);
  f32x16 O[4];
#pragma unroll
  for (int d = 0; d < 4; ++d)
#pragma unroll
    for (int i = 0; i < 16; ++i) O[d][i] = 0.f;
  float m = -1e30f, l = 0.f;
  const int lrow = tid >> 4, lc = tid & 15;
  if (SAMPLE) {
    u32x4 kv = {0u, 0u, 0u, 0u}, vv = {0u, 0u, 0u, 0u};
    kv = *(const u32x4*)(Kb + (size_t)(MP + b * 32 + lrow) * QP + hd * 128 + lc * 8);
    vv = *(const u32x4*)(Vb + (size_t)(MP + b * 32 + lrow) * QP + hd * 128 + lc * 8);
    const u32x4 z = {0u, 0u, 0u, 0u};
    *(LAS u32x4*)(lds + lrow * KP + lc * 16) = kv;
    *(LAS u32x4*)(lds + 64 * KP + lrow * VP + lc * 16) = vv;
    *(LAS u32x4*)(lds + (lrow + 32) * KP + lc * 16) = z;
    *(LAS u32x4*)(lds + 64 * KP + (lrow + 32) * VP + lc * 16) = z;
  } else {
#pragma unroll
    for (int i = 0; i < 2; ++i) {
      const size_t kr = (size_t)(b * SEQ + lrow + 32 * i) * QP + hd * 128 + lc * 8;
      const u32x4 kv = *(const u32x4*)(Kb + kr);
      const u32x4 vv = *(const u32x4*)(Vb + kr);
      *(LAS u32x4*)(lds + (lrow + 32 * i) * KP + lc * 16) = kv;
      *(LAS u32x4*)(lds + 64 * KP + (lrow + 32 * i) * VP + lc * 16) = vv;
    }
  }
  __syncthreads();
  const int i16 = lane & 15, q4 = i16 >> 2, p4 = i16 & 3, blk = (lane >> 4) & 1;
  for (int t = 0; t < nt; ++t) {
    const bool more = t + 1 < nt;
    u32x4 sk[2], sv[2];
    f32x4 fk[4], fv[4];
    if (more) {
      if (SAMPLE) {
#pragma unroll
        for (int i = 0; i < 2; ++i) {
          const size_t src = (((size_t)b * 2048 + (size_t)t * 64 + lrow + 32 * i) * 4 + hd) * 128 + lc * 8;
          fk[2 * i] = *(const f32x4*)(p.cache_k + src); fk[2 * i + 1] = *(const f32x4*)(p.cache_k + src + 4);
          fv[2 * i] = *(const f32x4*)(p.cache_v + src); fv[2 * i + 1] = *(const f32x4*)(p.cache_v + src + 4);
        }
      } else {
#pragma unroll
        for (int i = 0; i < 2; ++i) {
          const size_t kr = (size_t)(b * SEQ + (t + 1) * 64 + lrow + 32 * i) * QP + hd * 128 + lc * 8;
          sk[i] = *(const u32x4*)(Kb + kr);
          sv[i] = *(const u32x4*)(Vb + kr);
        }
      }
    }
    if (active && t < my_nt) {
      const ldsp Kl = lds + (t & 1) * ASTG, Vl = Kl + 64 * KP;
      f32x16 S[2];
#pragma unroll
      for (int kb = 0; kb < 2; ++kb) {
#pragma unroll
        for (int i = 0; i < 16; ++i) S[kb][i] = 0.f;
#pragma unroll
        for (int ks = 0; ks < 4; ++ks) {
          const bf16x8 kf = *(const LAS bf16x8*)(Kl + (32 * kb + r) * KP + (j * 64 + 16 * ks + 8 * h) * 2);
          S[kb] = MFMA(kf, qf[ks], S[kb]);
        }
      }
      if (SAMPLE && t == 0) {
#pragma unroll
        for (int i = 0; i < 16; ++i) S[1][i] = -1e30f;
      }
      float mx = S[0][0];
#pragma unroll
      for (int i = 1; i < 16; ++i) mx = fmaxf(mx, S[0][i]);
#pragma unroll
      for (int i = 0; i < 16; ++i) mx = fmaxf(mx, S[1][i]);
      mx = fmaxf(mx, __shfl_xor(mx, 32));
      const float mnew = fmaxf(m, mx);
      if (__any(mx > m + 6.f)) {
        const float alpha = __builtin_amdgcn_exp2f(m - mnew);
#pragma unroll
        for (int d = 0; d < 4; ++d)
#pragma unroll
          for (int i = 0; i < 16; ++i) O[d][i] *= alpha;
        l *= alpha; m = mnew;
      }
      float ls = 0.f;
#pragma unroll
      for (int kb = 0; kb < 2; ++kb)
#pragma unroll
        for (int i = 0; i < 16; ++i) { const float pp = __builtin_amdgcn_exp2f(S[kb][i] - m); S[kb][i] = pp; ls += pp; }
      l += ls;
#pragma unroll
      for (int kb = 0; kb < 2; ++kb)
#pragma unroll
        for (int s = 0; s < 2; ++s) {
          u32x4 pu = {pk2(S[kb][8 * s + 0], S[kb][8 * s + 1]), pk2(S[kb][8 * s + 2], S[kb][8 * s + 3]), pk2(S[kb][8 * s + 4], S[kb][8 * s + 5]), pk2(S[kb][8 * s + 6], S[kb][8 * s + 7])};
          const bf16x8 pf = __builtin_bit_cast(bf16x8, pu);
          const ldsp vb = Vl + (32 * kb + 16 * s + 4 * h + q4) * VP + blk * 32 + p4 * 8;
#pragma unroll
          for (int d = 0; d < 4; ++d) {
            const s16x4 lo = vtr(vb + d * 64), hi = vtr(vb + 8 * VP + d * 64);
            const bf16x8 vf = __builtin_shufflevector(lo, hi, 0, 1, 2, 3, 4, 5, 6, 7);
            O[d] = MFMA(vf, pf, O[d]);
          }
        }
    }
    if (more) {
      const ldsp wb = lds + ((t + 1) & 1) * ASTG;
      if (SAMPLE) {
#pragma unroll
        for (int i = 0; i < 2; ++i) {
          const u32x4 kk = {pk2(fk[2 * i][0], fk[2 * i][1]), pk2(fk[2 * i][2], fk[2 * i][3]), pk2(fk[2 * i + 1][0], fk[2 * i + 1][1]), pk2(fk[2 * i + 1][2], fk[2 * i + 1][3])};
          const u32x4 vv = {pk2(fv[2 * i][0], fv[2 * i][1]), pk2(fv[2 * i][2], fv[2 * i][3]), pk2(fv[2 * i + 1][0], fv[2 * i + 1][1]), pk2(fv[2 * i + 1][2], fv[2 * i + 1][3])};
          *(LAS u32x4*)(wb + (lrow + 32 * i) * KP + lc * 16) = kk;
          *(LAS u32x4*)(wb + 64 * KP + (lrow + 32 * i) * VP + lc * 16) = vv;
        }
      } else {
#pragma unroll
        for (int i = 0; i < 2; ++i) {
          *(LAS u32x4*)(wb + (lrow + 32 * i) * KP + lc * 16) = sk[i];
          *(LAS u32x4*)(wb + 64 * KP + (lrow + 32 * i) * VP + lc * 16) = sv[i];
        }
      }
    }
    __syncthreads();
  }
  const float lt = l + __shfl_xor(l, 32);
  const float inv = 1.f / lt;
  LAS float* cb = (LAS float*)lds;
  if (j == 1 && active) {
#pragma unroll
    for (int d = 0; d < 4; ++d)
#pragma unroll
      for (int i = 0; i < 16; ++i) cb[(rs * 64 + d * 16 + i) * 64 + lane] = O[d][i] * inv;
  }
  __syncthreads();
  if (j == 0 && active) {
    float ss = 0.f;
#pragma unroll
    for (int d = 0; d < 4; ++d)
#pragma unroll
      for (int i = 0; i < 16; ++i) { const float o = O[d][i] * inv - lam * cb[(rs * 64 + d * 16 + i) * 64 + lane]; O[d][i] = o; ss += o * o; }
    ss += __shfl_xor(ss, 32);
    const float rn = rsqrtf(ss * (1.f / 128.f) + 1e-5f) * 0.8f;
#pragma unroll
    for (int d = 0; d < 4; ++d)
#pragma unroll
      for (int g = 0; g < 4; ++g) {
        const int d0 = d * 32 + 8 * g + 4 * h;
        const f32x4 sg = *(const f32x4*)(p.subln_g + d0);
        const u32x2 ga = *(const u32x2*)(Ga + (size_t)qrow * QP + hd * 128 + d0);
        u32x2 w = {pk2(O[d][4 * g + 0] * rn * sg[0] * bflo(ga[0]), O[d][4 * g + 1] * rn * sg[1] * bfhi(ga[0])),
                   pk2(O[d][4 * g + 2] * rn * sg[2] * bflo(ga[1]), O[d][4 * g + 3] * rn * sg[3] * bfhi(ga[1]))};
        *(u32x2*)(Mix + (size_t)qrow * HP + hd * 128 + d0) = w;
      }
  }
  __syncthreads();
}


constexpr int PSTG = 32768;
DI void attn_prompt(const Params& p, ldsp lds, const int tid, const float lam, const int b, const int hd, const int x) {
  const int wave = __builtin_amdgcn_readfirstlane(tid >> 6), lane = tid & 63, r = lane & 31, h = lane >> 5, rs = wave & 3, j = wave >> 2;
  const bf16_t* Qb = (const bf16_t*)(p.ws + WS_Q);
  const bf16_t* Kb = (const bf16_t*)(p.ws + WS_K);
  const bf16_t* Vb = (const bf16_t*)(p.ws + WS_V);
  const bf16_t* Ga = (const bf16_t*)(p.ws + WS_GA);
  bf16_t* Mix = (bf16_t*)(p.ws + WS_MIX);
  const int nt = 2 * x + 2;
  const int my_nt = 2 * x + 1 + (rs >> 1);
  const int qrow = b * SEQ + x * 128 + 32 * rs + r;
  bf16x8 qf[4];
#pragma unroll
  for (int ks = 0; ks < 4; ++ks) qf[ks] = *(const bf16x8*)(Qb + (size_t)qrow * QP + hd * 128 + j * 64 + ks * 16 + h * 8);
  f32x16 O[4];
#pragma unroll
  for (int d = 0; d < 4; ++d)
#pragma unroll
    for (int i = 0; i < 16; ++i) O[d][i] = 0.f;
  float m = -1e30f, l = 0.f;
  const int lrw = lane >> 4, lcp = lane & 15;
  const int krow0 = wave * 8 + lrw;
  const bf16_t* gk0 = Kb + (size_t)(b * SEQ + krow0) * QP + hd * 128 + ((lcp ^ (krow0 & 15)) * 8);
  const bf16_t* gk1 = Kb + (size_t)(b * SEQ + krow0 + 4) * QP + hd * 128 + ((lcp ^ ((krow0 + 4) & 15)) * 8);
  const bf16_t* gv0 = Vb + (size_t)(b * SEQ + krow0) * QP + hd * 128 + ((lcp ^ ((krow0 & 3) << 2)) * 8);
  const bf16_t* gv1 = Vb + (size_t)(b * SEQ + krow0 + 4) * QP + hd * 128 + ((lcp ^ (((krow0 + 4) & 3) << 2)) * 8);
  const ldsp lk = lds + wave * 2048, lv = lds + 16384 + wave * 2048;
#define ATT_ISSUE(t_) do { const int st_ = ((t_) & 3) * PSTG; const size_t go_ = (size_t)(t_) * 64 * QP; \
    glds16(gk0 + go_, lk + st_); glds16(gk1 + go_, lk + st_ + 1024); glds16(gv0 + go_, lv + st_); glds16(gv1 + go_, lv + st_ + 1024); } while (0)
  ATT_ISSUE(0); ATT_ISSUE(1);
  const int i16 = lane & 15, q4 = i16 >> 2, p4 = i16 & 3, blk = (lane >> 4) & 1;
  const int kswz = r & 15;
  const unsigned vaddr0 = (unsigned)(size_t)(lds + 16384) + (unsigned)((4 * h + q4) * 256 + blk * 32 + p4 * 8);
  const unsigned voff0 = (unsigned)((0 ^ q4) * 64), voff1 = (unsigned)((1 ^ q4) * 64), voff2 = (unsigned)((2 ^ q4) * 64), voff3 = (unsigned)((3 ^ q4) * 64);
  const int np = nt >> 1;
  for (int tp = 0; tp < np; ++tp) {
    wait_vm<0>();
    raw_barrier();
    if (tp + 1 < np) { ATT_ISSUE(2 * tp + 2); ATT_ISSUE(2 * tp + 3); }
#pragma unroll 1
    for (int u = 0; u < 2; ++u) {
    const int t = 2 * tp + u;
    if (t < my_nt) {
      const ldsp Kl = lds + (t & 3) * PSTG, Vl = Kl + 16384;
      f32x16 S[2];
      bf16x8 kf[8];
#pragma unroll
      for (int kb = 0; kb < 2; ++kb)
#pragma unroll
        for (int ks = 0; ks < 4; ++ks) kf[kb * 4 + ks] = *(const LAS bf16x8*)(Kl + (32 * kb + r) * 256 + (((j * 8 + 2 * ks + h) ^ kswz) * 16));
      __builtin_amdgcn_s_setprio(1);
#pragma unroll
      for (int kb = 0; kb < 2; ++kb) {
#pragma unroll
        for (int i = 0; i < 16; ++i) S[kb][i] = 0.f;
#pragma unroll
        for (int ks = 0; ks < 4; ++ks) S[kb] = MFMA(kf[kb * 4 + ks], qf[ks], S[kb]);
      }
      __builtin_amdgcn_s_setprio(0);
      float mx = S[0][0];
#pragma unroll
      for (int i = 1; i < 16; ++i) mx = fmaxf(mx, S[0][i]);
#pragma unroll
      for (int i = 0; i < 16; ++i) mx = fmaxf(mx, S[1][i]);
      {
        typedef __attribute__((ext_vector_type(2))) unsigned u2v;
        const u2v sw = __builtin_amdgcn_permlane32_swap(__float_as_uint(mx), __float_as_uint(mx), false, false);
        mx = fmaxf(__uint_as_float(sw[0]), __uint_as_float(sw[1]));
      }
      const float mnew = fmaxf(m, mx);
      if (__any(mx > m + 6.f)) {
        const float alpha = __builtin_amdgcn_exp2f(m - mnew);
#pragma unroll
        for (int d = 0; d < 4; ++d)
#pragma unroll
          for (int i = 0; i < 16; ++i) O[d][i] *= alpha;
        l *= alpha; m = mnew;
      }
      float ls = 0.f;
#pragma unroll
      for (int kb = 0; kb < 2; ++kb)
#pragma unroll
        for (int i = 0; i < 16; ++i) { const float pp = __builtin_amdgcn_exp2f(S[kb][i] - m); S[kb][i] = pp; ls += pp; }
      l += ls;
      bf16x8 pfr[4];
#pragma unroll
      for (int kb = 0; kb < 2; ++kb)
#pragma unroll
        for (int s = 0; s < 2; ++s) {
          u32x4 pu = {pk2(S[kb][8 * s + 0], S[kb][8 * s + 1]), pk2(S[kb][8 * s + 2], S[kb][8 * s + 3]), pk2(S[kb][8 * s + 4], S[kb][8 * s + 5]), pk2(S[kb][8 * s + 6], S[kb][8 * s + 7])};
          pfr[kb * 2 + s] = __builtin_bit_cast(bf16x8, pu);
        }
      {
        const unsigned vbase = vaddr0 + (unsigned)((t & 3) * PSTG);
        const unsigned va0 = vbase + voff0, va1 = vbase + voff1, va2 = vbase + voff2, va3 = vbase + voff3;
        s16x4 lo[4], hi[4], lo2[4], hi2[4];
#define TR_ISSUE(L, H, G) do { \
          asm volatile("ds_read_b64_tr_b16 %0, %1 offset:%2" : "=v"(L[0]) : "v"(va0), "n"((G) * 4096)); \
          asm volatile("ds_read_b64_tr_b16 %0, %1 offset:%2" : "=v"(H[0]) : "v"(va0), "n"((G) * 4096 + 2048)); \
          asm volatile("ds_read_b64_tr_b16 %0, %1 offset:%2" : "=v"(L[1]) : "v"(va1), "n"((G) * 4096)); \
          asm volatile("ds_read_b64_tr_b16 %0, %1 offset:%2" : "=v"(H[1]) : "v"(va1), "n"((G) * 4096 + 2048)); \
          asm volatile("ds_read_b64_tr_b16 %0, %1 offset:%2" : "=v"(L[2]) : "v"(va2), "n"((G) * 4096)); \
          asm volatile("ds_read_b64_tr_b16 %0, %1 offset:%2" : "=v"(H[2]) : "v"(va2), "n"((G) * 4096 + 2048)); \
          asm volatile("ds_read_b64_tr_b16 %0, %1 offset:%2" : "=v"(L[3]) : "v"(va3), "n"((G) * 4096)); \
          asm volatile("ds_read_b64_tr_b16 %0, %1 offset:%2" : "=v"(H[3]) : "v"(va3), "n"((G) * 4096 + 2048)); } while (0)
#define TR_WAIT(L, H) asm volatile("s_waitcnt lgkmcnt(0)" : "+v"(L[0]), "+v"(H[0]), "+v"(L[1]), "+v"(H[1]), "+v"(L[2]), "+v"(H[2]), "+v"(L[3]), "+v"(H[3]))
#define TR_MMA(L, H, G) do { __builtin_amdgcn_s_setprio(1); _Pragma("unroll") for (int d = 0; d < 4; ++d) { \
          const bf16x8 vf = __builtin_shufflevector(L[d], H[d], 0, 1, 2, 3, 4, 5, 6, 7); O[d] = MFMA(vf, pfr[G], O[d]); } __builtin_amdgcn_s_setprio(0); } while (0)
        TR_ISSUE(lo, hi, 0);
        TR_WAIT(lo, hi); TR_ISSUE(lo2, hi2, 1); TR_MMA(lo, hi, 0);
        TR_WAIT(lo2, hi2); TR_ISSUE(lo, hi, 2); TR_MMA(lo2, hi2, 1);
        TR_WAIT(lo, hi); TR_ISSUE(lo2, hi2, 3); TR_MMA(lo, hi, 2);
        TR_WAIT(lo2, hi2); TR_MMA(lo2, hi2, 3);
#undef TR_ISSUE
#undef TR_WAIT
#undef TR_MMA
      }
    }
    }
  }
#undef ATT_ISSUE
  raw_barrier();
  const float lt = l + __shfl_xor(l, 32);
  const float inv = 1.f / lt;
  LAS float* cb = (LAS float*)lds;
  if (j == 1) {
#pragma unroll
    for (int d = 0; d < 4; ++d)
#pragma unroll
      for (int i = 0; i < 16; ++i) cb[(rs * 64 + d * 16 + i) * 64 + lane] = O[d][i] * inv;
  }
  __syncthreads();
  if (j == 0) {
    float ss = 0.f;
#pragma unroll
    for (int d = 0; d < 4; ++d)
#pragma unroll
      for (int i = 0; i < 16; ++i) { const float o = O[d][i] * inv - lam * cb[(rs * 64 + d * 16 + i) * 64 + lane]; O[d][i] = o; ss += o * o; }
    ss += __shfl_xor(ss, 32);
    const float rn = rsqrtf(ss * (1.f / 128.f) + 1e-5f) * 0.8f;
#pragma unroll
    for (int d = 0; d < 4; ++d)
#pragma unroll
      for (int g = 0; g < 4; ++g) {
        const int d0 = d * 32 + 8 * g + 4 * h;
        const f32x4 sg = *(const f32x4*)(p.subln_g + d0);
        const u32x2 ga = *(const u32x2*)(Ga + (size_t)qrow * QP + hd * 128 + d0);
        u32x2 w = {pk2(O[d][4 * g + 0] * rn * sg[0] * bflo(ga[0]), O[d][4 * g + 1] * rn * sg[1] * bfhi(ga[0])),
                   pk2(O[d][4 * g + 2] * rn * sg[2] * bflo(ga[1]), O[d][4 * g + 3] * rn * sg[3] * bfhi(ga[1]))};
        *(u32x2*)(Mix + (size_t)qrow * HP + hd * 128 + d0) = w;
      }
  }
  __syncthreads();
}

constexpr int PPITCH = 1040;
DI void pool_unit2(const Params& p, ldsp lds, const int u, const int tid) {
  const int wave = __builtin_amdgcn_readfirstlane(tid >> 6), lane = tid & 63, r = lane & 31, h = lane >> 5;
  const bf16_t* Ub = (const bf16_t*)(p.ws + WS_U);
  const bf16_t* Gp = (const bf16_t*)(p.ws + WS_GP);
  bf16_t* Mix = (bf16_t*)(p.ws + WS_MIX);
  const int R0 = u * 64;
  const bool smp = R0 >= MP;
  const int sl0 = R0 & (SEQ - 1);
#pragma unroll 1
  for (int bt = 0; bt < 1; ++bt) {
    u32x4 vals[12];
#pragma unroll
    for (int i = 0; i < 12; ++i) {
      const int idx = tid + 512 * (bt * 12 + i);
      const int vr = idx >> 6, c = idx & 63;
      const int th = vr >= 47 ? 1 : 0, v = vr - 47 * th;
      u32x4 val = {0u, 0u, 0u, 0u};
      if (idx < 6016) {
        if (!smp) {
          if (sl0 + 32 * th - 15 + v >= 0) val = *(const u32x4*)(Ub + (size_t)(R0 + 32 * th - 15 + v) * QP + c * 8);
        } else {
          const int b = ((R0 - MP) >> 5) + th;
          if (v >= 15) val = *(const u32x4*)(Ub + (size_t)(MP + b * 32 + v - 15) * QP + c * 8);
          else {
            const float* hp = p.state_pool + ((size_t)b * 15 + v) * 512 + c * 8;
            const f32x4 h0 = *(const f32x4*)hp, h1 = *(const f32x4*)(hp + 4);
            val[0] = pk2(h0[0], h0[1]); val[1] = pk2(h0[2], h0[3]); val[2] = pk2(h1[0], h1[1]); val[3] = pk2(h1[2], h1[3]);
          }
        }
      }
      vals[i] = val;
    }
#pragma unroll
    for (int i = 0; i < 12; ++i) {
      const int idx = tid + 512 * (bt * 12 + i);
      if (idx < 6016) *(LAS u32x4*)(lds + (idx >> 6) * PPITCH + (idx & 63) * 16) = vals[i];
    }
  }
  __syncthreads();
  {
    const int g = wave >> 1, th = wave & 1;
    const int W = 2 << g;
    const int s = sl0 + 32 * th + r;
    const float icnt = smp ? (1.f / (float)W) : (1.f / (float)(s + 1 < W ? s + 1 : W));
    const bf16_t* WpT = (const bf16_t*)(p.ws + WS_WPT) + g * 16384;
    f32x16 acc[4];
#pragma unroll
    for (int d = 0; d < 4; ++d)
#pragma unroll
      for (int i = 0; i < 16; ++i) acc[d][i] = 0.f;
    const ldsp rowp = lds + (th * 47 + 15 + r) * PPITCH + (g * 128 + 8 * h) * 2;
#pragma unroll 1
    for (int ks = 0; ks < 8; ++ks) {
      bf16x8 bfr[4];
#pragma unroll
      for (int d = 0; d < 4; ++d) bfr[d] = *(const bf16x8*)(WpT + (size_t)(d * 32 + r) * 128 + 16 * ks + 8 * h);
      const ldsp bp = rowp + ks * 32;
      float sum[8], cur[8];
      {
        const u32x4 uu = *(const LAS u32x4*)bp;
#pragma unroll
        for (int e = 0; e < 4; ++e) { cur[2 * e] = bflo(uu[e]); cur[2 * e + 1] = bfhi(uu[e]); sum[2 * e] = cur[2 * e]; sum[2 * e + 1] = cur[2 * e + 1]; }
      }
#pragma unroll 2
      for (int wi = 1; wi < W; ++wi) {
        const u32x4 uu = *(const LAS u32x4*)(bp - wi * PPITCH);
#pragma unroll
        for (int e = 0; e < 4; ++e) { sum[2 * e] += bflo(uu[e]); sum[2 * e + 1] += bfhi(uu[e]); }
      }
      u32x4 au;
#pragma unroll
      for (int e = 0; e < 4; ++e) au[e] = pk2(sum[2 * e] * icnt - cur[2 * e], sum[2 * e + 1] * icnt - cur[2 * e + 1]);
      const bf16x8 af = __builtin_bit_cast(bf16x8, au);
#pragma unroll
      for (int d = 0; d < 4; ++d) acc[d] = MFMA(af, bfr[d], acc[d]);
    }
#pragma unroll
    for (int d = 0; d < 4; ++d) {
      const int col = g * 128 + d * 32 + r;
      const float sc = p.pool_scale[col];
#pragma unroll
      for (int i = 0; i < 16; ++i)
        *(LAS bf16_t*)(lds + (th * 47 + 15 + crow(i, h)) * PPITCH + col * 2) = (bf16_t)pk2(acc[d][i] * sc, 0.f);
    }
  }
  __syncthreads();
#pragma unroll
  for (int i = 0; i < 8; ++i) {
    const int idx = tid + 512 * i;
    const int row = idx >> 6, c = idx & 63;
    const int th = row >> 5, rr = row & 31;
    const u32x4 a = *(const LAS u32x4*)(lds + (th * 47 + 15 + rr) * PPITCH + c * 16);
    const u32x4 gq = *(const u32x4*)(Gp + (size_t)(R0 + row) * QP + c * 8);
    u32x4 w;
#pragma unroll
    for (int e = 0; e < 4; ++e) w[e] = pk2(bflo(a[e]) * bflo(gq[e]), bfhi(a[e]) * bfhi(gq[e]));
    *(u32x4*)(Mix + (size_t)(R0 + row) * HP + 512 + c * 8) = w;
  }
  __syncthreads();
}

DI void phase2(const Params& p, ldsp lds, const int tid) {
  const int lane = tid & 63;
  const float d1 = wave_sum(p.lq1[lane] * p.lk1[lane]);
  const float d2 = wave_sum(p.lq2[lane] * p.lk2[lane]);
  const float lam = __expf(d1) - __expf(d2) + 0.2f;
  const int q = blockIdx.x & 7;
  unsigned* ctr = (unsigned*)(p.ws + WS_BAR) + p.bar_idx * BAR_REGION_WORDS + 2304 + q * 64;
  volatile LAS int* slot = (volatile LAS int*)(lds + LDS_BYTES - 64);
  for (;;) {
    if (tid == 0) *slot = (int)__hip_atomic_fetch_add(ctr, 1u, __ATOMIC_RELAXED, __HIP_MEMORY_SCOPE_AGENT);
    __syncthreads();
    const int item = *slot;
    __syncthreads();
    if (item >= 114) break;
    int kind, arg;
    if (item < 42) { kind = 0; arg = 63 - item; }
    else if (item < 58) { kind = 1; arg = q + 8 * (item - 42); }
    else if (item < 75) { kind = 0; arg = 79 - item; }
    else if (item < 109) { kind = 2; arg = q + 8 * (item - 75); }
    else { kind = 0; arg = 113 - item; }
    if (!((p.p2mask >> kind) & 1)) continue;
    int tl = tid;
    asm volatile("" : "+v"(tl));
    if (kind == 0) attn_prompt(p, lds, tl, lam, q >> 2, q & 3, arg);
    else if (kind == 1) attn_unit<true>(p, lds, tl, lam, arg >> 2, arg & 3, 0);
    else pool_unit2(p, lds, arg, tl);
  }
}

DI void phase4(const Params& p, const int tid) {
  const int wave = tid >> 6, lane = tid & 63;
  for (int row = blockIdx.x * 8 + wave; row < MT; row += gridDim.x * 16) {
    const int row2 = row + gridDim.x * 8;
    const bool has2 = row2 < MT;
    const bf16_t* yp = (const bf16_t*)(p.ws + WS_YPRE) + (size_t)row * HP;
    const bf16_t* yp2 = (const bf16_t*)(p.ws + WS_YPRE) + (size_t)(has2 ? row2 : row) * HP;
    f32x4 v[4], w4[4]; float ss = 0.f, ss2 = 0.f;
#pragma unroll
    for (int i = 0; i < 4; ++i) {
      const u32x2 a = *(const u32x2*)(yp + lane * 4 + 256 * i), b2 = *(const u32x2*)(yp2 + lane * 4 + 256 * i);
      v[i][0] = bflo(a[0]); v[i][1] = bfhi(a[0]); v[i][2] = bflo(a[1]); v[i][3] = bfhi(a[1]);
      w4[i][0] = bflo(b2[0]); w4[i][1] = bfhi(b2[0]); w4[i][2] = bflo(b2[1]); w4[i][3] = bfhi(b2[1]);
    }
#pragma unroll
    for (int i = 0; i < 4; ++i) {
      ss += v[i][0] * v[i][0] + v[i][1] * v[i][1] + v[i][2] * v[i][2] + v[i][3] * v[i][3];
      ss2 += w4[i][0] * w4[i][0] + w4[i][1] * w4[i][1] + w4[i][2] * w4[i][2] + w4[i][3] * w4[i][3];
    }
    ss = wave_sum(ss); ss2 = wave_sum(ss2);
    const float rs = rsqrtf(ss * (1.f / DM) + 1e-6f), rs2 = rsqrtf(ss2 * (1.f / DM) + 1e-6f);
#pragma unroll
    for (int i = 0; i < 4; ++i) {
      const f32x4 g = *(const f32x4*)(p.final_g + lane * 4 + 256 * i);
      f32x4 w = {v[i][0] * rs * g[0], v[i][1] * rs * g[1], v[i][2] * rs * g[2], v[i][3] * rs * g[3]};
      *(f32x4*)(p.out + O_Y + (size_t)row * DM + lane * 4 + 256 * i) = w;
      if (has2) {
        f32x4 w2 = {w4[i][0] * rs2 * g[0], w4[i][1] * rs2 * g[1], w4[i][2] * rs2 * g[2], w4[i][3] * rs2 * g[3]};
        *(f32x4*)(p.out + O_Y + (size_t)row2 * DM + lane * 4 + 256 * i) = w2;
      }
    }
  }
}

DI unsigned xcc_id() { return (unsigned)__builtin_amdgcn_s_getreg((3 << 11) | 20) & 0xFu; }
DI unsigned ld_rlx(unsigned* p) { return __hip_atomic_load(p, __ATOMIC_RELAXED, __HIP_MEMORY_SCOPE_AGENT); }
DI unsigned add_rlx(unsigned* p, unsigned v) { return __hip_atomic_fetch_add(p, v, __ATOMIC_RELAXED, __HIP_MEMORY_SCOPE_AGENT); }
DI void gridbar_post(unsigned* base, ldsp lds, const int tid) {
  if (tid == 0) {
    volatile LAS unsigned* st = (volatile LAS unsigned*)(lds + LDS_BYTES - 64);
    const unsigned xcc = xcc_id();
    add_rlx(base + 64 + 64 * xcc, 1u);
    add_rlx(base, 1u);
    st[4] = xcc; st[7] = 0u;
  }
}
DI void gridbar_complete(unsigned* base, ldsp lds, const int tid) {
  if (tid == 0) {
    volatile LAS unsigned* st = (volatile LAS unsigned*)(lds + LDS_BYTES - 64);
    while (ld_rlx(base) < gridDim.x) __builtin_amdgcn_s_sleep(4);
    unsigned nx = 0;
    for (int x = 0; x < 16; ++x) nx += (ld_rlx(base + 64 + 64 * x) != 0u) ? 1u : 0u;
    st[5] = ld_rlx(base + 64 + 64 * st[4]); st[6] = nx;
  }
}
DI void grid_barrier(unsigned* base, ldsp lds, const int tid) {
  asm volatile("s_waitcnt vmcnt(0)" ::: "memory");
  __syncthreads();
  if (tid == 0) {
    volatile LAS unsigned* st = (volatile LAS unsigned*)(lds + LDS_BYTES - 64);
    const unsigned xcc = st[4], nloc = st[5], nx = st[6], k = st[7] + 1u;
    st[7] = k;
    const unsigned old = add_rlx(base + 1152 + 64 * xcc, 1u);
    if (old + 1u == nloc * k) {
      __builtin_amdgcn_fence(__ATOMIC_RELEASE, "agent");
      add_rlx(base + 2240, 1u);
    }
    while (ld_rlx(base + 2240) < nx * k) __builtin_amdgcn_s_sleep(4);
    __builtin_amdgcn_fence(__ATOMIC_ACQUIRE, "agent");
  }
  __syncthreads();
}

__global__ void __launch_bounds__(512) mega(Params p) {
  extern __shared__ __attribute__((aligned(16))) unsigned char lds_raw[];
  const ldsp lds = (ldsp)lds_raw;
  const int tid = threadIdx.x;
  cg::grid_group grid = cg::this_grid();
  const int lo = p.ph_lo, hi = p.ph_hi;
#ifndef PHMASK
#define PHMASK 31
#endif
  if ((PHMASK & 1) && lo <= 0 && 0 < hi) phase0(p, lds, tid);
  unsigned* const gbase = (unsigned*)(p.ws + WS_BAR) + p.bar_idx * BAR_REGION_WORDS;
  gridbar_post(gbase, lds, tid);
  bool gb_ready = false;
#define GRID_BARRIER() do { if (!gb_ready) { gridbar_complete(gbase, lds, tid); gb_ready = true; } grid_barrier(gbase, lds, tid); } while (0)
  if (lo < -1000) grid.sync();
  if (lo <= 0 && 1 < hi) GRID_BARRIER();
  if ((PHMASK & 2) && lo <= 1 && 1 < hi) {
    EpiIn e{(const float*)(p.ws + WS_ROPE), p.out, p.ws};
    gemm_glds<64, 2, 5, EpiIn, true>((const bf16_t*)(p.ws + WS_HB), (const bf16_t*)(p.ws + WS_WINT), MP, MS, NIN, DM, lds, tid, e, p.mode);
    gemm_glds<256, 4, 4>((const bf16_t*)(p.ws + WS_HB), (const bf16_t*)(p.ws + WS_WINT), 0, MP, NIN, DM, lds, tid, e, p.mode);
  }
  if (lo <= 1 && 2 < hi) GRID_BARRIER();
  if ((PHMASK & 4) && lo <= 2 && 2 < hi) phase2(p, lds, tid);
  if (lo <= 2 && 3 < hi) GRID_BARRIER();
  if ((PHMASK & 8) && lo <= 3 && 3 < hi) {
    EpiOut e{p.x_prompt, p.x_sample, (bf16_t*)(p.ws + WS_YPRE)};
    gemm_glds<128, 2, 5>((const bf16_t*)(p.ws + WS_MIX), (const bf16_t*)(p.ws + WS_WOUTT), 0, MP, DM, DM, lds, tid, e, p.mode);
    gemm_glds<64, 2, 5>((const bf16_t*)(p.ws + WS_MIX), (const bf16_t*)(p.ws + WS_WOUTT), MP, MS, DM, DM, lds, tid, e, p.mode);
  }
  if (lo <= 3 && 4 < hi) GRID_BARRIER();
  if ((PHMASK & 16) && lo <= 4 && 4 < hi) phase4(p, tid);
}

extern "C" void kernel_launch(void* const* d_in, const int* in_sizes, int n_in, void* d_out, int out_size, void* d_ws, size_t ws_size, hipStream_t stream) {
  static int grid_blocks = 0;
  if (!grid_blocks) {
    int dev = 0, cus = 0, per_cu = 0;
    hipGetDevice(&dev);
    hipDeviceGetAttribute(&cus, hipDeviceAttributeMultiprocessorCount, dev);
    if (hipFuncSetAttribute((const void*)mega, hipFuncAttributeMaxDynamicSharedMemorySize, LDS_BYTES) != hipSuccess) fprintf(stderr, "hipFuncSetAttribute failed\n");
    if (hipOccupancyMaxActiveBlocksPerMultiprocessor(&per_cu, (const void*)mega, 512, LDS_BYTES) != hipSuccess || per_cu < 1) { fprintf(stderr, "occupancy query gave %d\n", per_cu); per_cu = 1; }
    (void)hipGetLastError();
    if (cus <= 0) cus = 256;
    grid_blocks = cus * per_cu;
  }
  Params p{};
  p.x_prompt = (const float*)d_in[0]; p.x_sample = (const float*)d_in[1]; p.cache_k = (const float*)d_in[2]; p.cache_v = (const float*)d_in[3];
  p.state_pool = (const float*)d_in[4]; p.norm_g = (const float*)d_in[5]; p.w_in = (const float*)d_in[6];
  p.lq1 = (const float*)d_in[7]; p.lk1 = (const float*)d_in[8]; p.lq2 = (const float*)d_in[9]; p.lk2 = (const float*)d_in[10];
  p.subln_g = (const float*)d_in[11]; p.w_pool = (const float*)d_in[12]; p.pool_scale = (const float*)d_in[13]; p.w_out = (const float*)d_in[14]; p.final_g = (const float*)d_in[15];
  p.out = (float*)d_out; p.ws = (unsigned char*)d_ws; p.p2mask = 7;
  (void)hipMemsetAsync((unsigned char*)d_ws + WS_BAR, 0, 2 * BAR_REGION_WORDS * 4, stream);
#if NLAUNCH == 1
#ifndef PROBE_K
  p.ph_lo = 0; p.ph_hi = 5;
  void* args[] = {&p};
  hipError_t e = hipLaunchCooperativeKernel((const void*)mega, dim3(grid_blocks), dim3(512), args, LDS_BYTES, stream);
  if (e != hipSuccess) fprintf(stderr, "cooperative launch failed: %s (grid %d)\n", hipGetErrorString(e), grid_blocks);
#else
  Params p2 = p;
  p.ph_lo = 0; p.ph_hi = PROBE_K + 1; p2.ph_lo = PROBE_K; p2.ph_hi = 5; p2.bar_idx = 1;
#ifdef PROBE_MASK
  p2.p2mask = PROBE_MASK;
#endif
#ifdef PROBE_MODE
  p2.mode = PROBE_MODE; p2.ph_hi = PROBE_K + 1; p.ph_hi = 5;
#endif
  void* args[] = {&p};
  void* args2[] = {&p2};
  hipError_t e = hipLaunchCooperativeKernel((const void*)mega, dim3(grid_blocks), dim3(512), args, LDS_BYTES, stream);
  if (e == hipSuccess) e = hipLaunchCooperativeKernel((const void*)mega, dim3(grid_blocks), dim3(512), args2, LDS_BYTES, stream);
  if (e != hipSuccess) fprintf(stderr, "cooperative launch failed: %s (grid %d)\n", hipGetErrorString(e), grid_blocks);
#endif
#else
  for (int ph = 0; ph < 5; ++ph) {
    p.ph_lo = ph; p.ph_hi = ph + 1;
    hipLaunchKernelGGL(mega, dim3(grid_blocks), dim3(512), LDS_BYTES, stream, p);
  }
#endif
}
```

```cpp
#include <hip/hip_runtime.h>
#include <hip/hip_cooperative_groups.h>
#include <cstdio>
namespace cg = cooperative_groups;

#ifndef NLAUNCH
#define NLAUNCH 1
#endif

#define LAS __attribute__((address_space(3)))
#define DI __device__ __forceinline__
typedef __attribute__((ext_vector_type(8))) short bf16x8;
typedef __attribute__((ext_vector_type(4))) short s16x4;
typedef __attribute__((ext_vector_type(16))) float f32x16;
typedef __attribute__((ext_vector_type(4))) float f32x4;
typedef __attribute__((ext_vector_type(2))) float f32x2;
typedef __attribute__((ext_vector_type(4))) unsigned u32x4;
typedef __attribute__((ext_vector_type(2))) unsigned u32x2;
typedef __attribute__((ext_vector_type(2))) __bf16 bf16x2_t;
typedef unsigned short bf16_t;
typedef LAS unsigned char* ldsp;

#define MFMA(a, b, c) __builtin_amdgcn_mfma_f32_32x32x16_bf16((a), (b), (c), 0, 0, 0)

constexpr int DM = 1024, SEQ = 8192, MP = 16384, MS = 1024, MT = MP + MS, NIN = 3072;
constexpr size_t MiB = 1u << 20;
constexpr int HP = 1088, QP = 576;
constexpr size_t WS_WINT = 0, WS_WOUTT = 8 * MiB, WS_WPT = 11 * MiB, WS_ROPE = 12 * MiB, WS_HB = 16 * MiB;
constexpr size_t WS_Q = 56 * MiB, WS_SEG = 20 * MiB;
constexpr size_t WS_K = WS_Q + WS_SEG, WS_V = WS_Q + 2 * WS_SEG, WS_GA = WS_Q + 3 * WS_SEG, WS_U = WS_Q + 4 * WS_SEG, WS_GP = WS_Q + 5 * WS_SEG;
constexpr size_t WS_MIX = 176 * MiB;
constexpr size_t WS_BAR = 255 * MiB;
constexpr int BAR_REGION_WORDS = 4096;
constexpr size_t WS_YPRE = 256 * MiB;
constexpr size_t O_Y = 0, O_KP = 17825792, O_VP = 26214400, O_PP = 34603008, O_KS = 34618368, O_VS = 35142656, O_PS = 35666944;
constexpr float QSCALE = 0.125f * 1.4426950408889634f;
constexpr int LDS_BYTES = 147456;

struct Params {
  const float *x_prompt, *x_sample, *cache_k, *cache_v, *state_pool, *norm_g, *w_in, *lq1, *lk1, *lq2, *lk2, *subln_g, *w_pool, *pool_scale, *w_out, *final_g;
  float* out; unsigned char* ws; int ph_lo, ph_hi, bar_idx, p2mask, mode, pad;
};

DI unsigned pk2(float lo, float hi) { f32x2 v = {lo, hi}; bf16x2_t b = __builtin_convertvector(v, bf16x2_t); return __builtin_bit_cast(unsigned, b); }
DI float bflo(unsigned u) { return __uint_as_float(u << 16); }
DI float bfhi(unsigned u) { return __uint_as_float(u & 0xffff0000u); }
DI float wave_sum(float v) {
#pragma unroll
  for (int o = 32; o; o >>= 1) v += __shfl_xor(v, o);
  return v;
}
DI int crow(int i, int h) { return (i & 3) + 8 * (i >> 2) + 4 * h; }
DI float silu(float v) { return v * __builtin_amdgcn_rcpf(1.f + __builtin_amdgcn_exp2f(-1.4426950408889634f * v)); }
DI int row_pos(int row) { return row < MP ? (row & (SEQ - 1)) : 2048 + ((row - MP) & 31); }
DI const float* x_row(const Params& p, int row) { return row < MP ? p.x_prompt + (size_t)row * DM : p.x_sample + (size_t)(row - MP) * DM; }

DI void phase0(const Params& p, ldsp lds, const int tid) {
  const int wave = tid >> 6, lane = tid & 63;
  const int G = gridDim.x, bid = blockIdx.x;
  bf16_t* WinT = (bf16_t*)(p.ws + WS_WINT);
  bf16_t* WoutT = (bf16_t*)(p.ws + WS_WOUTT);
  bf16_t* WpT = (bf16_t*)(p.ws + WS_WPT);
  for (int it = bid * 8 + wave; it < 1040 * 8; it += G * 8) {
    const int t = it >> 3, sub = it & 7;
    const float* W; bf16_t* WT; int ldw, ldt, k0, n0;
    if (t < 768) { W = p.w_in; WT = WinT; ldw = NIN; ldt = HP; k0 = (t / 48) * 64; n0 = (t % 48) * 64; }
    else if (t < 1024) { const int u = t - 768; W = p.w_out; WT = WoutT; ldw = DM; ldt = HP; k0 = (u >> 4) * 64; n0 = (u & 15) * 64; }
    else { const int u = t - 1024; const int g = u >> 2; W = p.w_pool + g * 16384; WT = WpT + g * 16384; ldw = 128; ldt = 128; k0 = ((u >> 1) & 1) * 64; n0 = (u & 1) * 64; }
    const float* src = W + (size_t)(k0 + lane) * ldw + n0 + sub * 8;
    const f32x4 a0 = *(const f32x4*)src, a1 = *(const f32x4*)(src + 4);
    bf16_t* dstp = WT + (size_t)(n0 + sub * 8) * ldt + k0 + lane;
    dstp[0 * (size_t)ldt] = (bf16_t)pk2(a0[0], 0.f); dstp[1 * (size_t)ldt] = (bf16_t)pk2(a0[1], 0.f);
    dstp[2 * (size_t)ldt] = (bf16_t)pk2(a0[2], 0.f); dstp[3 * (size_t)ldt] = (bf16_t)pk2(a0[3], 0.f);
    dstp[4 * (size_t)ldt] = (bf16_t)pk2(a1[0], 0.f); dstp[5 * (size_t)ldt] = (bf16_t)pk2(a1[1], 0.f);
    dstp[6 * (size_t)ldt] = (bf16_t)pk2(a1[2], 0.f); dstp[7 * (size_t)ldt] = (bf16_t)pk2(a1[3], 0.f);
  }
  {
    bf16_t* Hb = (bf16_t*)(p.ws + WS_HB);
    for (int row = bid * 8 + wave; row < MT; row += G * 32) {
      f32x4 v[4][4]; float ss[4];
#pragma unroll
      for (int q = 0; q < 4; ++q) {
        const int rw = row + q * G * 8;
        const float* x = x_row(p, rw < MT ? rw : row);
#pragma unroll
        for (int i = 0; i < 4; ++i) v[q][i] = *(const f32x4*)(x + lane * 4 + 256 * i);
      }
#pragma unroll
      for (int q = 0; q < 4; ++q) {
        float a = 0.f;
#pragma unroll
        for (int i = 0; i < 4; ++i) a += v[q][i][0] * v[q][i][0] + v[q][i][1] * v[q][i][1] + v[q][i][2] * v[q][i][2] + v[q][i][3] * v[q][i][3];
        ss[q] = rsqrtf(wave_sum(a) * (1.f / DM) + 1e-6f);
      }
#pragma unroll
      for (int i = 0; i < 4; ++i) {
        const f32x4 g = *(const f32x4*)(p.norm_g + lane * 4 + 256 * i);
#pragma unroll
        for (int q = 0; q < 4; ++q) {
          const int rw = row + q * G * 8;
          if (rw < MT) {
            const float rs = ss[q];
            u32x2 w = {pk2(v[q][i][0] * rs * g[0], v[q][i][1] * rs * g[1]), pk2(v[q][i][2] * rs * g[2], v[q][i][3] * rs * g[3])};
            *(u32x2*)(Hb + (size_t)rw * HP + lane * 4 + 256 * i) = w;
          }
        }
      }
    }
  }
}

constexpr int BK = 64, LDP = 144;

template <int BM, int WGM, class Epi>
DI void gemm_phase(const bf16_t* __restrict__ A, const bf16_t* __restrict__ Bt, const int Mrows, const int N, const int K, ldsp lds, const int tid, const Epi& epi) {
  constexpr int BN = 256, A_BYTES = BM * LDP, STAGE = (BM + BN) * LDP, NA = BM / 64, WROWS = BM / WGM, WCOLS = BN / (8 / WGM), TM = WROWS / 32, TN = WCOLS / 32;
  const int wave = tid >> 6, lane = tid & 63, r = lane & 31, h = lane >> 5, wm = wave % WGM, wn = wave / WGM;
  const int tiles_n = N / BN, ntiles = (Mrows / BM) * tiles_n, nk = K / BK;
  const int lrow = tid >> 3, lc = tid & 7;
  for (int t = blockIdx.x; t < ntiles; t += gridDim.x) {
    const int m0 = (t / tiles_n) * BM, n0 = (t % tiles_n) * BN;
    const bf16_t* ag = A + (size_t)(m0 + lrow) * K + lc * 8;
    const bf16_t* bg = Bt + (size_t)(n0 + lrow) * K + lc * 8;
    u32x4 ra[NA], rb[4];
    f32x16 acc[TM][TN];
#pragma unroll
    for (int a = 0; a < TM; ++a)
#pragma unroll
      for (int b = 0; b < TN; ++b)
#pragma unroll
        for (int i = 0; i < 16; ++i) acc[a][b][i] = 0.f;
#pragma unroll
    for (int i = 0; i < NA; ++i) ra[i] = *(const u32x4*)(ag + (size_t)i * 64 * K);
#pragma unroll
    for (int i = 0; i < 4; ++i) rb[i] = *(const u32x4*)(bg + (size_t)i * 64 * K);
#pragma unroll
    for (int i = 0; i < NA; ++i) *(LAS u32x4*)(lds + (lrow + 64 * i) * LDP + lc * 16) = ra[i];
#pragma unroll
    for (int i = 0; i < 4; ++i) *(LAS u32x4*)(lds + A_BYTES + (lrow + 64 * i) * LDP + lc * 16) = rb[i];
    __syncthreads();
    for (int kt = 0; kt < nk; ++kt) {
      const bool more = kt + 1 < nk;
      if (more) {
#pragma unroll
        for (int i = 0; i < NA; ++i) ra[i] = *(const u32x4*)(ag + (size_t)i * 64 * K + (kt + 1) * BK);
#pragma unroll
        for (int i = 0; i < 4; ++i) rb[i] = *(const u32x4*)(bg + (size_t)i * 64 * K + (kt + 1) * BK);
      }
      const ldsp sa = lds + (kt & 1) * STAGE + (wm * WROWS + r) * LDP + h * 16;
      const ldsp sb = lds + (kt & 1) * STAGE + A_BYTES + (wn * WCOLS + r) * LDP + h * 16;
#pragma unroll
      for (int ks = 0; ks < 4; ++ks) {
        bf16x8 af[TM], bfr[TN];
#pragma unroll
        for (int a = 0; a < TM; ++a) af[a] = *(const LAS bf16x8*)(sa + a * 32 * LDP + ks * 32);
#pragma unroll
        for (int b = 0; b < TN; ++b) bfr[b] = *(const LAS bf16x8*)(sb + b * 32 * LDP + ks * 32);
#pragma unroll
        for (int a = 0; a < TM; ++a)
#pragma unroll
          for (int b = 0; b < TN; ++b) acc[a][b] = MFMA(af[a], bfr[b], acc[a][b]);
      }
      if (more) {
        const ldsp wbase = lds + ((kt + 1) & 1) * STAGE;
#pragma unroll
        for (int i = 0; i < NA; ++i) *(LAS u32x4*)(wbase + (lrow + 64 * i) * LDP + lc * 16) = ra[i];
#pragma unroll
        for (int i = 0; i < 4; ++i) *(LAS u32x4*)(wbase + A_BYTES + (lrow + 64 * i) * LDP + lc * 16) = rb[i];
      }
      __syncthreads();
    }
#pragma unroll
    for (int a = 0; a < TM; ++a)
#pragma unroll
      for (int b = 0; b < TN; ++b) epi(acc[a][b], m0 + wm * WROWS + a * 32, n0 + wn * WCOLS + b * 32, r, h);
  }
}


#define GAS __attribute__((address_space(1)))
DI void glds16(const void* g, ldsp l) { __builtin_amdgcn_global_load_lds((const GAS unsigned*)g, (LAS unsigned*)l, 16, 0, 0); }
template <int N> DI void wait_vm() { asm volatile("s_waitcnt vmcnt(%0)" ::"n"(N) : "memory"); }
DI void raw_barrier() { asm volatile("s_waitcnt lgkmcnt(0)" ::: "memory"); __builtin_amdgcn_s_barrier(); }

template <int PER, int MAXS> DI void wait_stages(const int rem) {
  if (rem >= MAXS) wait_vm<MAXS * PER>();
  else if constexpr (MAXS > 0) wait_stages<PER, MAXS - 1>(rem);
}

template <int BM, int WGM, int NS, class Epi, bool REV = false>
DI void gemm_glds(const bf16_t* __restrict__ A, const bf16_t* __restrict__ Bt, const int row0, const int Mrows, const int N, const int K, ldsp lds, const int tid, const Epi& epi, const int mode) {
  constexpr int BN = 256, A_BYTES = BM * 64, STAGE = (BM + BN) * 64;
  static_assert(NS * STAGE <= LDS_BYTES - 64, "LDS ring too large");
  constexpr int WGN = 8 / WGM, WROWS = BM / WGM, WCOLS = BN / WGN, TM = WROWS / 32, TN = WCOLS / 32, NAI = (BM >= 128) ? BM / 128 : 1, AW = (BM >= 128) ? 8 : BM / 16, PER = NAI + 2;
  const int wave = __builtin_amdgcn_readfirstlane(tid >> 6), lane = tid & 63, r = lane & 31, h = lane >> 5, wm = wave % WGM, wn = wave / WGM;
  const int tiles_n = N / BN, ntiles = (Mrows / BM) * tiles_n, nk = K / 32;
  const int lr = lane >> 2, lchunk = (lane & 3) ^ ((lr >> 2) & 3);
  const int swz = (r >> 2) & 3;
  for (int t = REV ? (int)(gridDim.x - 1 - blockIdx.x) : (int)blockIdx.x; t < ntiles; t += gridDim.x) {
    const int m0 = row0 + (t / tiles_n) * BM, n0 = (t % tiles_n) * BN;
    const bf16_t* ga = A + (size_t)(m0 + (wave % AW) * NAI * 16 + lr) * HP + lchunk * 8;
    const bf16_t* gb = Bt + (size_t)(n0 + wave * 32 + lr) * HP + lchunk * 8;
    const ldsp la = lds + (wave % AW) * NAI * 1024, lb = lds + A_BYTES + wave * 2048;
    f32x16 acc[TM][TN];
#pragma unroll
    for (int a = 0; a < TM; ++a)
#pragma unroll
      for (int b = 0; b < TN; ++b)
#pragma unroll
        for (int i = 0; i < 16; ++i) acc[a][b][i] = 0.f;
#define GEMM_ISSUE(kt_, slot_) do { const int st_ = (slot_) * STAGE; \
      _Pragma("unroll") for (int i_ = 0; i_ < NAI; ++i_) glds16(ga + (size_t)i_ * 16 * HP + (kt_) * 32, la + st_ + i_ * 1024); \
      _Pragma("unroll") for (int i_ = 0; i_ < 2; ++i_) glds16(gb + (size_t)i_ * 16 * HP + (kt_) * 32, lb + st_ + i_ * 1024); } while (0)
#pragma unroll
    for (int i = 0; i < NS - 1; ++i) GEMM_ISSUE(i, i);
    int rs_ = 0, ws_ = NS - 1;
    for (int kt = 0; kt < nk; ++kt) {
      wait_stages<PER, NS - 2>(nk - 1 - kt);
      raw_barrier();
      if (kt + NS - 1 < nk) GEMM_ISSUE(kt + NS - 1, ws_);
      const ldsp sa = lds + rs_ * STAGE + (wm * WROWS + r) * 64;
      const ldsp sb = lds + rs_ * STAGE + A_BYTES + (wn * WCOLS + r) * 64;
      rs_ = (rs_ + 1 == NS) ? 0 : rs_ + 1; ws_ = (ws_ + 1 == NS) ? 0 : ws_ + 1;
#pragma unroll
      for (int ks = 0; ks < 2; ++ks) {
        const int co = ((ks * 2 + h) ^ swz) * 16;
        bf16x8 af[TM], bfr[TN];
#pragma unroll
        for (int a = 0; a < TM; ++a) af[a] = *(const LAS bf16x8*)(sa + a * 2048 + co);
#pragma unroll
        for (int b = 0; b < TN; ++b) bfr[b] = *(const LAS bf16x8*)(sb + b * 2048 + co);
#pragma unroll
        for (int a = 0; a < TM; ++a)
#pragma unroll
          for (int b = 0; b < TN; ++b) acc[a][b] = MFMA(af[a], bfr[b], acc[a][b]);
      }
    }
#undef GEMM_ISSUE
    if constexpr (Epi::KIND == 1) {
      raw_barrier();
#pragma unroll
      for (int a = 0; a < TM; ++a) epi.template rowblock<TN>(acc[a], m0 + wm * WROWS + a * 32, n0 + wn * WCOLS, lane, lds + wave * 16896);
    } else {
      static_assert(TN == 2, "64-column wave-tile epilogue");
      raw_barrier();
      epi.template tile64<TM>(acc, m0 + wm * WROWS, n0 + wn * WCOLS, lane, lds + wave * 17408);
    }
    raw_barrier();
  }
}

struct EpiIn {
  static constexpr int KIND = 1;
  const float* rope; float* out; unsigned char* ws;
  template <int TN>
  DI void rowblock(const f32x16* acc, const int mb, const int nb0, const int lane, ldsp wl) const {
    constexpr int SP = TN * 32 + 4, LPR = TN * 2, RPP = 64 / LPR, NP = 32 / RPP;
    const int r = lane & 31, h = lane >> 5;
    LAS float* st = (LAS float*)wl;
#pragma unroll
    for (int b = 0; b < TN; ++b)
#pragma unroll
      for (int i = 0; i < 16; ++i) st[crow(i, h) * SP + b * 32 + r] = acc[b][i];
    const int seg = nb0 >> 9, c0 = nb0 & 511;
    bf16_t* dst = (bf16_t*)(ws + WS_Q + (size_t)seg * WS_SEG);
    const int cg = lane % LPR, col_l = cg * 16;
#pragma unroll 2
    for (int pass = 0; pass < NP; ++pass) {
      const int row_l = pass * RPP + (lane / LPR);
      const int row = mb + row_l, c = c0 + col_l;
      f32x4 v[4];
#pragma unroll
      for (int k = 0; k < 4; ++k) v[k] = *(const LAS f32x4*)(st + row_l * SP + col_l + 4 * k);
      if (seg < 2 && (col_l & 63) == 0) {
        const float fpos = (float)row_pos(row);
        const float rc[8] = {0.15915494309189535f, 0.03086376340470123f, 0.005985185712713705f, 0.001160663641240061f, 0.00022507907903927653f, 4.364795279280289e-05f, 8.464330808241401e-06f, 1.6414262627950345e-06f};
        float cs[16];
#pragma unroll
        for (int i = 0; i < 8; ++i) { const float fr = __builtin_amdgcn_fractf(fpos * rc[i]); cs[2 * i] = __builtin_amdgcn_cosf(fr); cs[2 * i + 1] = __builtin_amdgcn_sinf(fr); }
#pragma unroll
        for (int i = 0; i < 8; ++i) {
          const float a = v[i >> 2][i & 3], bb = v[2 + (i >> 2)][i & 3];
          v[i >> 2][i & 3] = a * cs[2 * i] - bb * cs[2 * i + 1];
          v[2 + (i >> 2)][i & 3] = bb * cs[2 * i] + a * cs[2 * i + 1];
        }
      }
      if (seg == 0) {
#pragma unroll
        for (int k = 0; k < 4; ++k) v[k] *= QSCALE;
      } else if (seg == 1 || seg == 2) {
        float* o = (row < MP) ? out + (seg == 1 ? O_KP : O_VP) + (size_t)row * 512 + c : out + (seg == 1 ? O_KS : O_VS) + (size_t)(row - MP) * 512 + c;
#pragma unroll
        for (int k = 0; k < 4; ++k) *(f32x4*)(o + 4 * k) = v[k];
      } else if (seg == 3 || seg == 5) {
#pragma unroll
        for (int k = 0; k < 4; ++k)
#pragma unroll
          for (int e = 0; e < 4; ++e) v[k][e] = silu(v[k][e]);
      } else {
        float* o = nullptr;
        if (row < MP) { const int s = row & (SEQ - 1); if (s >= SEQ - 15) o = out + O_PP + ((size_t)(row >> 13) * 15 + (s - (SEQ - 15))) * 512 + c; }
        else { const int s = (row - MP) & 31; if (s >= 17) o = out + O_PS + ((size_t)((row - MP) >> 5) * 15 + (s - 17)) * 512 + c; }
        if (o) {
#pragma unroll
          for (int k = 0; k < 4; ++k) *(f32x4*)(o + 4 * k) = v[k];
        }
      }
      const u32x4 w0 = {pk2(v[0][0], v[0][1]), pk2(v[0][2], v[0][3]), pk2(v[1][0], v[1][1]), pk2(v[1][2], v[1][3])};
      const u32x4 w1 = {pk2(v[2][0], v[2][1]), pk2(v[2][2], v[2][3]), pk2(v[3][0], v[3][1]), pk2(v[3][2], v[3][3])};
      *(u32x4*)(dst + (size_t)row * QP + c) = w0;
      *(u32x4*)(dst + (size_t)row * QP + c + 8) = w1;
    }
  }
  DI void operator()(const f32x16& acc, const int mb, const int nb, const int r, const int h) const {
    const int seg = nb >> 9;
    const int c = (nb & 511) + r;
    bf16_t* dst = (bf16_t*)(ws + WS_Q + (size_t)seg * WS_SEG);
    const bool do_rope = (seg < 2) && ((nb & 63) == 0);
#pragma unroll
    for (int i = 0; i < 16; ++i) {
      const int row = mb + crow(i, h);
      float v = acc[i];
      if (do_rope) {
        const float pv = __shfl_xor(v, 8);
        if (r < 16) {
          const f32x2 cs = *(const f32x2*)(rope + ((size_t)row_pos(row) * 8 + (r & 7)) * 2);
          v = (r < 8) ? (v * cs[0] - pv * cs[1]) : (v * cs[0] + pv * cs[1]);
        }
      }
      if (seg == 0) {
        dst[(size_t)row * QP + c] = (bf16_t)pk2(v * QSCALE, 0.f);
      } else if (seg == 1 || seg == 2) {
        float* o = (row < MP) ? out + (seg == 1 ? O_KP : O_VP) + (size_t)row * 512 + c : out + (seg == 1 ? O_KS : O_VS) + (size_t)(row - MP) * 512 + c;
        *o = v;
        dst[(size_t)row * QP + c] = (bf16_t)pk2(v, 0.f);
      } else if (seg == 3 || seg == 5) {
        dst[(size_t)row * QP + c] = (bf16_t)pk2(silu(v), 0.f);
      } else {
        dst[(size_t)row * QP + c] = (bf16_t)pk2(v, 0.f);
        if (row < MP) {
          const int s = row & (SEQ - 1);
          if (s >= SEQ - 15) out[O_PP + ((size_t)(row >> 13) * 15 + (s - (SEQ - 15))) * 512 + c] = v;
        } else {
          const int s = (row - MP) & 31;
          if (s >= 17) out[O_PS + ((size_t)((row - MP) >> 5) * 15 + (s - 17)) * 512 + c] = v;
        }
      }
    }
  }
};

struct EpiOut {
  static constexpr int KIND = 2;
  const float* xp; const float* xs; bf16_t* out;
  template <int TM>
  DI void tile64(const f32x16 (&acc)[TM][2], const int mb, const int nb, const int lane, ldsp wl) const {
    const int r = lane & 31, h = lane >> 5;
    LAS float* st = (LAS float*)wl;
    const int rq = lane >> 4, c4 = (lane & 15) * 4;
    f32x4 xv[TM * 8];
#pragma unroll
    for (int ps = 0; ps < TM * 8; ++ps) {
      const int row = mb + ps * 4 + rq;
      const float* x = row < MP ? xp + (size_t)row * DM : xs + (size_t)(row - MP) * DM;
      xv[ps] = *(const f32x4*)(x + nb + c4);
    }
#pragma unroll
    for (int a = 0; a < TM; ++a)
#pragma unroll
      for (int b = 0; b < 2; ++b)
#pragma unroll
        for (int i = 0; i < 16; ++i) st[(a * 32 + crow(i, h)) * 68 + b * 32 + r] = acc[a][b][i];
#pragma unroll
    for (int ps = 0; ps < TM * 8; ++ps) {
      const int row = mb + ps * 4 + rq;
      const f32x4 v = *(const LAS f32x4*)(st + (ps * 4 + rq) * 68 + c4);
      const f32x4 y4 = v + xv[ps];
      const u32x2 yb = {pk2(y4[0], y4[1]), pk2(y4[2], y4[3])};
      *(u32x2*)(out + (size_t)row * HP + nb + c4) = yb;
    }
  }
};

constexpr int KP = 272, VP = 320, ASTG = 64 * KP + 64 * VP;

DI s16x4 vtr(ldsp p) { return __builtin_bit_cast(s16x4, __builtin_amdgcn_ds_read_tr16_b64_v4i16((LAS s16x4*)p)); }

template <bool SAMPLE>
DI void attn_unit(const Params& p, ldsp lds, const int tid, const float lam, const int b, const int hd, const int x) {
  const int wave = tid >> 6, lane = tid & 63, r = lane & 31, h = lane >> 5, rs = wave & 3, j = wave >> 2;
  const bf16_t* Qb = (const bf16_t*)(p.ws + WS_Q);
  const bf16_t* Kb = (const bf16_t*)(p.ws + WS_K);
  const bf16_t* Vb = (const bf16_t*)(p.ws + WS_V);
  const bf16_t* Ga = (const bf16_t*)(p.ws + WS_GA);
  bf16_t* Mix = (bf16_t*)(p.ws + WS_MIX);
  const int nt = SAMPLE ? 33 : 2 * x + 2;
  const int my_nt = SAMPLE ? 33 : 2 * x + 1 + (rs >> 1);
  const bool active = SAMPLE ? (rs == 0) : true;
  const int row0 = SAMPLE ? MP + b * 32 : b * SEQ + x * 128;
  const int qrow = row0 + (SAMPLE ? 0 : 32 * rs) + r;
  bf16x8 qf[4];
#pragma unroll
  for (int ks = 0; ks < 4; ++ks) qf[ks] = *(const bf16x8*)(Qb + (size_t)qrow * QP + hd * 128 + j * 64 + ks * 16 + h * 8);
  f32x16 O[4];
#pragma unroll
  for (int d = 0; d < 4; ++d)
#pragma unroll
    for (int i = 0; i < 16; ++i) O[d][i] = 0.f;
  float m = -1e30f, l = 0.f;
  const int lrow = tid >> 4, lc = tid & 15;
  if (SAMPLE) {
    u32x4 kv = {0u, 0u, 0u, 0u}, vv = {0u, 0u, 0u, 0u};
    kv = *(const u32x4*)(Kb + (size_t)(MP + b * 32 + lrow) * QP + hd * 128 + lc * 8);
    vv = *(const u32x4*)(Vb + (size_t)(MP + b * 32 + lrow) * QP + hd * 128 + lc * 8);
    const u32x4 z = {0u, 0u, 0u, 0u};
    *(LAS u32x4*)(lds + lrow * KP + lc * 16) = kv;
    *(LAS u32x4*)(lds + 64 * KP + lrow * VP + lc * 16) = vv;
    *(LAS u32x4*)(lds + (lrow + 32) * KP + lc * 16) = z;
    *(LAS u32x4*)(lds + 64 * KP + (lrow + 32) * VP + lc * 16) = z;
  } else {
#pragma unroll
    for (int i = 0; i < 2; ++i) {
      const size_t kr = (size_t)(b * SEQ + lrow + 32 * i) * QP + hd * 128 + lc * 8;
      const u32x4 kv = *(const u32x4*)(Kb + kr);
      const u32x4 vv = *(const u32x4*)(Vb + kr);
      *(LAS u32x4*)(lds + (lrow + 32 * i) * KP + lc * 16) = kv;
      *(LAS u32x4*)(lds + 64 * KP + (lrow + 32 * i) * VP + lc * 16) = vv;
    }
  }
  __syncthreads();
  const int i16 = lane & 15, q4 = i16 >> 2, p4 = i16 & 3, blk = (lane >> 4) & 1;
  for (int t = 0; t < nt; ++t) {
    const bool more = t + 1 < nt;
    u32x4 sk[2], sv[2];
    f32x4 fk[4], fv[4];
    if (more) {
      if (SAMPLE) {
#pragma unroll
        for (int i = 0; i < 2; ++i) {
          const size_t src = (((size_t)b * 2048 + (size_t)t * 64 + lrow + 32 * i) * 4 + hd) * 128 + lc * 8;
          fk[2 * i] = *(const f32x4*)(p.cache_k + src); fk[2 * i + 1] = *(const f32x4*)(p.cache_k + src + 4);
          fv[2 * i] = *(const f32x4*)(p.cache_v + src); fv[2 * i + 1] = *(const f32x4*)(p.cache_v + src + 4);
        }
      } else {
#pragma unroll
        for (int i = 0; i < 2; ++i) {
          const size_t kr = (size_t)(b * SEQ + (t + 1) * 64 + lrow + 32 * i) * QP + hd * 128 + lc * 8;
          sk[i] = *(const u32x4*)(Kb + kr);
          sv[i] = *(const u32x4*)(Vb + kr);
        }
      }
    }
    if (active && t < my_nt) {
      const ldsp Kl = lds + (t & 1) * ASTG, Vl = Kl + 64 * KP;
      f32x16 S[2];
#pragma unroll
      for (int kb = 0; kb < 2; ++kb) {
#pragma unroll
        for (int i = 0; i < 16; ++i) S[kb][i] = 0.f;
#pragma unroll
        for (int ks = 0; ks < 4; ++ks) {
          const bf16x8 kf = *(const LAS bf16x8*)(Kl + (32 * kb + r) * KP + (j * 64 + 16 * ks + 8 * h) * 2);
          S[kb] = MFMA(kf, qf[ks], S[kb]);
        }
      }
      if (SAMPLE && t == 0) {
#pragma unroll
        for (int i = 0; i < 16; ++i) S[1][i] = -1e30f;
      }
      float mx = S[0][0];
#pragma unroll
      for (int i = 1; i < 16; ++i) mx = fmaxf(mx, S[0][i]);
#pragma unroll
      for (int i = 0; i < 16; ++i) mx = fmaxf(mx, S[1][i]);
      mx = fmaxf(mx, __shfl_xor(mx, 32));
      const float mnew = fmaxf(m, mx);
      if (__any(mx > m + 6.f)) {
        const float alpha = __builtin_amdgcn_exp2f(m - mnew);
#pragma unroll
        for (int d = 0; d < 4; ++d)
#pragma unroll
          for (int i = 0; i < 16; ++i) O[d][i] *= alpha;
        l *= alpha; m = mnew;
      }
      float ls = 0.f;
#pragma unroll
      for (int kb = 0; kb < 2; ++kb)
#pragma unroll
        for (int i = 0; i < 16; ++i) { const float pp = __builtin_amdgcn_exp2f(S[kb][i] - m); S[kb][i] = pp; ls += pp; }
      l += ls;
#pragma unroll
      for (int kb = 0; kb < 2; ++kb)
#pragma unroll
        for (int s = 0; s < 2; ++s) {
          u32x4 pu = {pk2(S[kb][8 * s + 0], S[kb][8 * s + 1]), pk2(S[kb][8 * s + 2], S[kb][8 * s + 3]), pk2(S[kb][8 * s + 4], S[kb][8 * s + 5]), pk2(S[kb][8 * s + 6], S[kb][8 * s + 7])};
          const bf16x8 pf = __builtin_bit_cast(bf16x8, pu);
          const ldsp vb = Vl + (32 * kb + 16 * s + 4 * h + q4) * VP + blk * 32 + p4 * 8;
#pragma unroll
          for (int d = 0; d < 4; ++d) {
            const s16x4 lo = vtr(vb + d * 64), hi = vtr(vb + 8 * VP + d * 64);
            const bf16x8 vf = __builtin_shufflevector(lo, hi, 0, 1, 2, 3, 4, 5, 6, 7);
            O[d] = MFMA(vf, pf, O[d]);
          }
        }
    }
    if (more) {
      const ldsp wb = lds + ((t + 1) & 1) * ASTG;
      if (SAMPLE) {
#pragma unroll
        for (int i = 0; i < 2; ++i) {
          const u32x4 kk = {pk2(fk[2 * i][0], fk[2 * i][1]), pk2(fk[2 * i][2], fk[2 * i][3]), pk2(fk[2 * i + 1][0], fk[2 * i + 1][1]), pk2(fk[2 * i + 1][2], fk[2 * i + 1][3])};
          const u32x4 vv = {pk2(fv[2 * i][0], fv[2 * i][1]), pk2(fv[2 * i][2], fv[2 * i][3]), pk2(fv[2 * i + 1][0], fv[2 * i + 1][1]), pk2(fv[2 * i + 1][2], fv[2 * i + 1][3])};
          *(LAS u32x4*)(wb + (lrow + 32 * i) * KP + lc * 16) = kk;
          *(LAS u32x4*)(wb + 64 * KP + (lrow + 32 * i) * VP + lc * 16) = vv;
        }
      } else {
#pragma unroll
        for (int i = 0; i < 2; ++i) {
          *(LAS u32x4*)(wb + (lrow + 32 * i) * KP + lc * 16) = sk[i];
          *(LAS u32x4*)(wb + 64 * KP + (lrow + 32 * i) * VP + lc * 16) = sv[i];
        }
      }
    }
    __syncthreads();
  }
  const float lt = l + __shfl_xor(l, 32);
  const float inv = 1.f / lt;
  LAS float* cb = (LAS float*)lds;
  if (j == 1 && active) {
#pragma unroll
    for (int d = 0; d < 4; ++d)
#pragma unroll
      for (int i = 0; i < 16; ++i) cb[(rs * 64 + d * 16 + i) * 64 + lane] = O[d][i] * inv;
  }
  __syncthreads();
  if (j == 0 && active) {
    float ss = 0.f;
#pragma unroll
    for (int d = 0; d < 4; ++d)
#pragma unroll
      for (int i = 0; i < 16; ++i) { const float o = O[d][i] * inv - lam * cb[(rs * 64 + d * 16 + i) * 64 + lane]; O[d][i] = o; ss += o * o; }
    ss += __shfl_xor(ss, 32);
    const float rn = rsqrtf(ss * (1.f / 128.f) + 1e-5f) * 0.8f;
#pragma unroll
    for (int d = 0; d < 4; ++d)
#pragma unroll
      for (int g = 0; g < 4; ++g) {
        const int d0 = d * 32 + 8 * g + 4 * h;
        const f32x4 sg = *(const f32x4*)(p.subln_g + d0);
        const u32x2 ga = *(const u32x2*)(Ga + (size_t)qrow * QP + hd * 128 + d0);
        u32x2 w = {pk2(O[d][4 * g + 0] * rn * sg[0] * bflo(ga[0]), O[d][4 * g + 1] * rn * sg[1] * bfhi(ga[0])),
                   pk2(O[d][4 * g + 2] * rn * sg[2] * bflo(ga[1]), O[d][4 * g + 3] * rn * sg[3] * bfhi(ga[1]))};
        *(u32x2*)(Mix + (size_t)qrow * HP + hd * 128 + d0) = w;
      }
  }
  __syncthreads();
}


constexpr int PSTG = 32768;
DI void attn_prompt(const Params& p, ldsp lds, const int tid, const float lam, const int b, const int hd, const int x) {
  const int wave = __builtin_amdgcn_readfirstlane(tid >> 6), lane = tid & 63, r = lane & 31, h = lane >> 5, rs = wave & 3, j = wave >> 2;
  const bf16_t* Qb = (const bf16_t*)(p.ws + WS_Q);
  const bf16_t* Kb = (const bf16_t*)(p.ws + WS_K);
  const bf16_t* Vb = (const bf16_t*)(p.ws + WS_V);
  const bf16_t* Ga = (const bf16_t*)(p.ws + WS_GA);
  bf16_t* Mix = (bf16_t*)(p.ws + WS_MIX);
  const int nt = 2 * x + 2;
  const int my_nt = 2 * x + 1 + (rs >> 1);
  const int qrow = b * SEQ + x * 128 + 32 * rs + r;
  bf16x8 qf[4];
#pragma unroll
  for (int ks = 0; ks < 4; ++ks) qf[ks] = *(const bf16x8*)(Qb + (size_t)qrow * QP + hd * 128 + j * 64 + ks * 16 + h * 8);
  f32x16 O[4];
#pragma unroll
  for (int d = 0; d < 4; ++d)
#pragma unroll
    for (int i = 0; i < 16; ++i) O[d][i] = 0.f;
  float m = -1e30f, l = 0.f;
  const int lrw = lane >> 4, lcp = lane & 15;
  const int krow0 = wave * 8 + lrw;
  const bf16_t* gk0 = Kb + (size_t)(b * SEQ + krow0) * QP + hd * 128 + ((lcp ^ (krow0 & 15)) * 8);
  const bf16_t* gk1 = Kb + (size_t)(b * SEQ + krow0 + 4) * QP + hd * 128 + ((lcp ^ ((krow0 + 4) & 15)) * 8);
  const bf16_t* gv0 = Vb + (size_t)(b * SEQ + krow0) * QP + hd * 128 + ((lcp ^ ((krow0 & 3) << 2)) * 8);
  const bf16_t* gv1 = Vb + (size_t)(b * SEQ + krow0 + 4) * QP + hd * 128 + ((lcp ^ (((krow0 + 4) & 3) << 2)) * 8);
  const ldsp lk = lds + wave * 2048, lv = lds + 16384 + wave * 2048;
#define ATT_ISSUE(t_) do { const int st_ = ((t_) & 3) * PSTG; const size_t go_ = (size_t)(t_) * 64 * QP; \
    glds16(gk0 + go_, lk + st_); glds16(gk1 + go_, lk + st_ + 1024); glds16(gv0 + go_, lv + st_); glds16(gv1 + go_, lv + st_ + 1024); } while (0)
  ATT_ISSUE(0); ATT_ISSUE(1);
  const int i16 = lane & 15, q4 = i16 >> 2, p4 = i16 & 3, blk = (lane >> 4) & 1;
  const int kswz = r & 15;
  const unsigned vaddr0 = (unsigned)(size_t)(lds + 16384) + (unsigned)((4 * h + q4) * 256 + blk * 32 + p4 * 8);
  const unsigned voff0 = (unsigned)((0 ^ q4) * 64), voff1 = (unsigned)((1 ^ q4) * 64), voff2 = (unsigned)((2 ^ q4) * 64), voff3 = (unsigned)((3 ^ q4) * 64);
  const int np = nt >> 1;
  for (int tp = 0; tp < np; ++tp) {
    wait_vm<0>();
    raw_barrier();
    if (tp + 1 < np) { ATT_ISSUE(2 * tp + 2); ATT_ISSUE(2 * tp + 3); }
#pragma unroll
    for (int u = 0; u < 2; ++u) {
    const int t = 2 * tp + u;
    if (t < my_nt) {
      const ldsp Kl = lds + (t & 3) * PSTG, Vl = Kl + 16384;
      f32x16 S[2];
      bf16x8 kf[8];
#pragma unroll
      for (int kb = 0; kb < 2; ++kb)
#pragma unroll
        for (int ks = 0; ks < 4; ++ks) kf[kb * 4 + ks] = *(const LAS bf16x8*)(Kl + (32 * kb + r) * 256 + (((j * 8 + 2 * ks + h) ^ kswz) * 16));
      __builtin_amdgcn_s_setprio(1);
#pragma unroll
      for (int kb = 0; kb < 2; ++kb) {
#pragma unroll
        for (int i = 0; i < 16; ++i) S[kb][i] = 0.f;
#pragma unroll
        for (int ks = 0; ks < 4; ++ks) S[kb] = MFMA(kf[kb * 4 + ks], qf[ks], S[kb]);
      }
      __builtin_amdgcn_s_setprio(0);
      float mx = S[0][0];
#pragma unroll
      for (int i = 1; i < 16; ++i) mx = fmaxf(mx, S[0][i]);
#pragma unroll
      for (int i = 0; i < 16; ++i) mx = fmaxf(mx, S[1][i]);
      {
        typedef __attribute__((ext_vector_type(2))) unsigned u2v;
        const u2v sw = __builtin_amdgcn_permlane32_swap(__float_as_uint(mx), __float_as_uint(mx), false, false);
        mx = fmaxf(__uint_as_float(sw[0]), __uint_as_float(sw[1]));
      }
      const float mnew = fmaxf(m, mx);
      if (__any(mx > m + 6.f)) {
        const float alpha = __builtin_amdgcn_exp2f(m - mnew);
#pragma unroll
        for (int d = 0; d < 4; ++d)
#pragma unroll
          for (int i = 0; i < 16; ++i) O[d][i] *= alpha;
        l *= alpha; m = mnew;
      }
      float ls = 0.f;
#pragma unroll
      for (int kb = 0; kb < 2; ++kb)
#pragma unroll
        for (int i = 0; i < 16; ++i) { const float pp = __builtin_amdgcn_exp2f(S[kb][i] - m); S[kb][i] = pp; ls += pp; }
      l += ls;
      bf16x8 pfr[4];
#pragma unroll
      for (int kb = 0; kb < 2; ++kb)
#pragma unroll
        for (int s = 0; s < 2; ++s) {
          u32x4 pu = {pk2(S[kb][8 * s + 0], S[kb][8 * s + 1]), pk2(S[kb][8 * s + 2], S[kb][8 * s + 3]), pk2(S[kb][8 * s + 4], S[kb][8 * s + 5]), pk2(S[kb][8 * s + 6], S[kb][8 * s + 7])};
          pfr[kb * 2 + s] = __builtin_bit_cast(bf16x8, pu);
        }
      {
        const unsigned vbase = vaddr0 + (unsigned)((t & 3) * PSTG);
        const unsigned va0 = vbase + voff0, va1 = vbase + voff1, va2 = vbase + voff2, va3 = vbase + voff3;
        s16x4 lo[4], hi[4], lo2[4], hi2[4];
#define TR_ISSUE(L, H, G) do { \
          asm volatile("ds_read_b64_tr_b16 %0, %1 offset:%2" : "=v"(L[0]) : "v"(va0), "n"((G) * 4096)); \
          asm volatile("ds_read_b64_tr_b16 %0, %1 offset:%2" : "=v"(H[0]) : "v"(va0), "n"((G) * 4096 + 2048)); \
          asm volatile("ds_read_b64_tr_b16 %0, %1 offset:%2" : "=v"(L[1]) : "v"(va1), "n"((G) * 4096)); \
          asm volatile("ds_read_b64_tr_b16 %0, %1 offset:%2" : "=v"(H[1]) : "v"(va1), "n"((G) * 4096 + 2048)); \
          asm volatile("ds_read_b64_tr_b16 %0, %1 offset:%2" : "=v"(L[2]) : "v"(va2), "n"((G) * 4096)); \
          asm volatile("ds_read_b64_tr_b16 %0, %1 offset:%2" : "=v"(H[2]) : "v"(va2), "n"((G) * 4096 + 2048)); \
          asm volatile("ds_read_b64_tr_b16 %0, %1 offset:%2" : "=v"(L[3]) : "v"(va3), "n"((G) * 4096)); \
          asm volatile("ds_read_b64_tr_b16 %0, %1 offset:%2" : "=v"(H[3]) : "v"(va3), "n"((G) * 4096 + 2048)); } while (0)
#define TR_WAIT(L, H) asm volatile("s_waitcnt lgkmcnt(0)" : "+v"(L[0]), "+v"(H[0]), "+v"(L[1]), "+v"(H[1]), "+v"(L[2]), "+v"(H[2]), "+v"(L[3]), "+v"(H[3]))
#define TR_MMA(L, H, G) do { __builtin_amdgcn_s_setprio(1); _Pragma("unroll") for (int d = 0; d < 4; ++d) { \
          const bf16x8 vf = __builtin_shufflevector(L[d], H[d], 0, 1, 2, 3, 4, 5, 6, 7); O[d] = MFMA(vf, pfr[G], O[d]); } __builtin_amdgcn_s_setprio(0); } while (0)
        TR_ISSUE(lo, hi, 0);
        TR_WAIT(lo, hi); TR_ISSUE(lo2, hi2, 1); TR_MMA(lo, hi, 0);
        TR_WAIT(lo2, hi2); TR_ISSUE(lo, hi, 2); TR_MMA(lo2, hi2, 1);
        TR_WAIT(lo, hi); TR_ISSUE(lo2, hi2, 3); TR_MMA(lo, hi, 2);
        TR_WAIT(lo2, hi2); TR_MMA(lo2, hi2, 3);
#undef TR_ISSUE
#undef TR_WAIT
#undef TR_MMA
      }
    }
    }
  }
#undef ATT_ISSUE
  raw_barrier();
  const float lt = l + __shfl_xor(l, 32);
  const float inv = 1.f / lt;
  LAS float* cb = (LAS float*)lds;
  if (j == 1) {
#pragma unroll
    for (int d = 0; d < 4; ++d)
#pragma unroll
      for (int i = 0; i < 16; ++i) cb[(rs * 64 + d * 16 + i) * 64 + lane] = O[d][i] * inv;
  }
  __syncthreads();
  if (j == 0) {
    float ss = 0.f;
#pragma unroll
    for (int d = 0; d < 4; ++d)
#pragma unroll
      for (int i = 0; i < 16; ++i) { const float o = O[d][i] * inv - lam * cb[(rs * 64 + d * 16 + i) * 64 + lane]; O[d][i] = o; ss += o * o; }
    ss += __shfl_xor(ss, 32);
    const float rn = rsqrtf(ss * (1.f / 128.f) + 1e-5f) * 0.8f;
#pragma unroll
    for (int d = 0; d < 4; ++d)
#pragma unroll
      for (int g = 0; g < 4; ++g) {
        const int d0 = d * 32 + 8 * g + 4 * h;
        const f32x4 sg = *(const f32x4*)(p.subln_g + d0);
        const u32x2 ga = *(const u32x2*)(Ga + (size_t)qrow * QP + hd * 128 + d0);
        u32x2 w = {pk2(O[d][4 * g + 0] * rn * sg[0] * bflo(ga[0]), O[d][4 * g + 1] * rn * sg[1] * bfhi(ga[0])),
                   pk2(O[d][4 * g + 2] * rn * sg[2] * bflo(ga[1]), O[d][4 * g + 3] * rn * sg[3] * bfhi(ga[1]))};
        *(u32x2*)(Mix + (size_t)qrow * HP + hd * 128 + d0) = w;
      }
  }
  __syncthreads();
}

constexpr int PPITCH = 1040;
DI void pool_unit2(const Params& p, ldsp lds, const int u, const int tid) {
  const int wave = __builtin_amdgcn_readfirstlane(tid >> 6), lane = tid & 63, r = lane & 31, h = lane >> 5;
  const bf16_t* Ub = (const bf16_t*)(p.ws + WS_U);
  const bf16_t* Gp = (const bf16_t*)(p.ws + WS_GP);
  bf16_t* Mix = (bf16_t*)(p.ws + WS_MIX);
  const int R0 = u * 64;
  const bool smp = R0 >= MP;
  const int sl0 = R0 & (SEQ - 1);
#pragma unroll 1
  for (int bt = 0; bt < 1; ++bt) {
    u32x4 vals[12];
#pragma unroll
    for (int i = 0; i < 12; ++i) {
      const int idx = tid + 512 * (bt * 12 + i);
      const int vr = idx >> 6, c = idx & 63;
      const int th = vr >= 47 ? 1 : 0, v = vr - 47 * th;
      u32x4 val = {0u, 0u, 0u, 0u};
      if (idx < 6016) {
        if (!smp) {
          if (sl0 + 32 * th - 15 + v >= 0) val = *(const u32x4*)(Ub + (size_t)(R0 + 32 * th - 15 + v) * QP + c * 8);
        } else {
          const int b = ((R0 - MP) >> 5) + th;
          if (v >= 15) val = *(const u32x4*)(Ub + (size_t)(MP + b * 32 + v - 15) * QP + c * 8);
          else {
            const float* hp = p.state_pool + ((size_t)b * 15 + v) * 512 + c * 8;
            const f32x4 h0 = *(const f32x4*)hp, h1 = *(const f32x4*)(hp + 4);
            val[0] = pk2(h0[0], h0[1]); val[1] = pk2(h0[2], h0[3]); val[2] = pk2(h1[0], h1[1]); val[3] = pk2(h1[2], h1[3]);
          }
        }
      }
      vals[i] = val;
    }
#pragma unroll
    for (int i = 0; i < 12; ++i) {
      const int idx = tid + 512 * (bt * 12 + i);
      if (idx < 6016) *(LAS u32x4*)(lds + (idx >> 6) * PPITCH + (idx & 63) * 16) = vals[i];
    }
  }
  __syncthreads();
  {
    const int g = wave >> 1, th = wave & 1;
    const int W = 2 << g;
    const int s = sl0 + 32 * th + r;
    const float icnt = smp ? (1.f / (float)W) : (1.f / (float)(s + 1 < W ? s + 1 : W));
    const bf16_t* WpT = (const bf16_t*)(p.ws + WS_WPT) + g * 16384;
    f32x16 acc[4];
#pragma unroll
    for (int d = 0; d < 4; ++d)
#pragma unroll
      for (int i = 0; i < 16; ++i) acc[d][i] = 0.f;
    const ldsp rowp = lds + (th * 47 + 15 + r) * PPITCH + (g * 128 + 8 * h) * 2;
#pragma unroll 1
    for (int ks = 0; ks < 8; ++ks) {
      bf16x8 bfr[4];
#pragma unroll
      for (int d = 0; d < 4; ++d) bfr[d] = *(const bf16x8*)(WpT + (size_t)(d * 32 + r) * 128 + 16 * ks + 8 * h);
      const ldsp bp = rowp + ks * 32;
      float sum[8], cur[8];
      {
        const u32x4 uu = *(const LAS u32x4*)bp;
#pragma unroll
        for (int e = 0; e < 4; ++e) { cur[2 * e] = bflo(uu[e]); cur[2 * e + 1] = bfhi(uu[e]); sum[2 * e] = cur[2 * e]; sum[2 * e + 1] = cur[2 * e + 1]; }
      }
#pragma unroll 2
      for (int wi = 1; wi < W; ++wi) {
        const u32x4 uu = *(const LAS u32x4*)(bp - wi * PPITCH);
#pragma unroll
        for (int e = 0; e < 4; ++e) { sum[2 * e] += bflo(uu[e]); sum[2 * e + 1] += bfhi(uu[e]); }
      }
      u32x4 au;
#pragma unroll
      for (int e = 0; e < 4; ++e) au[e] = pk2(sum[2 * e] * icnt - cur[2 * e], sum[2 * e + 1] * icnt - cur[2 * e + 1]);
      const bf16x8 af = __builtin_bit_cast(bf16x8, au);
#pragma unroll
      for (int d = 0; d < 4; ++d) acc[d] = MFMA(af, bfr[d], acc[d]);
    }
#pragma unroll
    for (int d = 0; d < 4; ++d) {
      const int col = g * 128 + d * 32 + r;
      const float sc = p.pool_scale[col];
#pragma unroll
      for (int i = 0; i < 16; ++i)
        *(LAS bf16_t*)(lds + (th * 47 + 15 + crow(i, h)) * PPITCH + col * 2) = (bf16_t)pk2(acc[d][i] * sc, 0.f);
    }
  }
  __syncthreads();
#pragma unroll
  for (int i = 0; i < 8; ++i) {
    const int idx = tid + 512 * i;
    const int row = idx >> 6, c = idx & 63;
    const int th = row >> 5, rr = row & 31;
    const u32x4 a = *(const LAS u32x4*)(lds + (th * 47 + 15 + rr) * PPITCH + c * 16);
    const u32x4 gq = *(const u32x4*)(Gp + (size_t)(R0 + row) * QP + c * 8);
    u32x4 w;
#pragma unroll
    for (int e = 0; e < 4; ++e) w[e] = pk2(bflo(a[e]) * bflo(gq[e]), bfhi(a[e]) * bfhi(gq[e]));
    *(u32x4*)(Mix + (size_t)(R0 + row) * HP + 512 + c * 8) = w;
  }
  __syncthreads();
}

DI void phase2(const Params& p, ldsp lds, const int tid) {
  const int lane = tid & 63;
  const float d1 = wave_sum(p.lq1[lane] * p.lk1[lane]);
  const float d2 = wave_sum(p.lq2[lane] * p.lk2[lane]);
  const float lam = __expf(d1) - __expf(d2) + 0.2f;
  const int q = blockIdx.x & 7;
  unsigned* ctr = (unsigned*)(p.ws + WS_BAR) + p.bar_idx * BAR_REGION_WORDS + 2304 + q * 64;
  volatile LAS int* slot = (volatile LAS int*)(lds + LDS_BYTES - 64);
  for (;;) {
    if (tid == 0) *slot = (int)__hip_atomic_fetch_add(ctr, 1u, __ATOMIC_RELAXED, __HIP_MEMORY_SCOPE_AGENT);
    __syncthreads();
    const int item = *slot;
    __syncthreads();
    if (item >= 114) break;
    int kind, arg;
    if (item < 42) { kind = 0; arg = 63 - item; }
    else if (item < 58) { kind = 1; arg = q + 8 * (item - 42); }
    else if (item < 75) { kind = 0; arg = 79 - item; }
    else if (item < 109) { kind = 2; arg = q + 8 * (item - 75); }
    else { kind = 0; arg = 113 - item; }
    if (!((p.p2mask >> kind) & 1)) continue;
    int tl = tid;
    asm volatile("" : "+v"(tl));
    if (kind == 0) attn_prompt(p, lds, tl, lam, q >> 2, q & 3, arg);
    else if (kind == 1) attn_unit<true>(p, lds, tl, lam, arg >> 2, arg & 3, 0);
    else pool_unit2(p, lds, arg, tl);
  }
}

DI void phase4(const Params& p, const int tid) {
  const int wave = tid >> 6, lane = tid & 63;
  for (int row = blockIdx.x * 8 + wave; row < MT; row += gridDim.x * 16) {
    const int row2 = row + gridDim.x * 8;
    const bool has2 = row2 < MT;
    const bf16_t* yp = (const bf16_t*)(p.ws + WS_YPRE) + (size_t)row * HP;
    const bf16_t* yp2 = (const bf16_t*)(p.ws + WS_YPRE) + (size_t)(has2 ? row2 : row) * HP;
    f32x4 v[4], w4[4]; float ss = 0.f, ss2 = 0.f;
#pragma unroll
    for (int i = 0; i < 4; ++i) {
      const u32x2 a = *(const u32x2*)(yp + lane * 4 + 256 * i), b2 = *(const u32x2*)(yp2 + lane * 4 + 256 * i);
      v[i][0] = bflo(a[0]); v[i][1] = bfhi(a[0]); v[i][2] = bflo(a[1]); v[i][3] = bfhi(a[1]);
      w4[i][0] = bflo(b2[0]); w4[i][1] = bfhi(b2[0]); w4[i][2] = bflo(b2[1]); w4[i][3] = bfhi(b2[1]);
    }
#pragma unroll
    for (int i = 0; i < 4; ++i) {
      ss += v[i][0] * v[i][0] + v[i][1] * v[i][1] + v[i][2] * v[i][2] + v[i][3] * v[i][3];
      ss2 += w4[i][0] * w4[i][0] + w4[i][1] * w4[i][1] + w4[i][2] * w4[i][2] + w4[i][3] * w4[i][3];
    }
    ss = wave_sum(ss); ss2 = wave_sum(ss2);
    const float rs = rsqrtf(ss * (1.f / DM) + 1e-6f), rs2 = rsqrtf(ss2 * (1.f / DM) + 1e-6f);
#pragma unroll
    for (int i = 0; i < 4; ++i) {
      const f32x4 g = *(const f32x4*)(p.final_g + lane * 4 + 256 * i);
      f32x4 w = {v[i][0] * rs * g[0], v[i][1] * rs * g[1], v[i][2] * rs * g[2], v[i][3] * rs * g[3]};
      *(f32x4*)(p.out + O_Y + (size_t)row * DM + lane * 4 + 256 * i) = w;
      if (has2) {
        f32x4 w2 = {w4[i][0] * rs2 * g[0], w4[i][1] * rs2 * g[1], w4[i][2] * rs2 * g[2], w4[i][3] * rs2 * g[3]};
        *(f32x4*)(p.out + O_Y + (size_t)row2 * DM + lane * 4 + 256 * i) = w2;
      }
    }
  }
}

DI unsigned xcc_id() { return (unsigned)__builtin_amdgcn_s_getreg((3 << 11) | 20) & 0xFu; }
DI unsigned ld_rlx(unsigned* p) { return __hip_atomic_load(p, __ATOMIC_RELAXED, __HIP_MEMORY_SCOPE_AGENT); }
DI unsigned add_rlx(unsigned* p, unsigned v) { return __hip_atomic_fetch_add(p, v, __ATOMIC_RELAXED, __HIP_MEMORY_SCOPE_AGENT); }
DI void gridbar_post(unsigned* base, ldsp lds, const int tid) {
  if (tid == 0) {
    volatile LAS unsigned* st = (volatile LAS unsigned*)(lds + LDS_BYTES - 64);
    const unsigned xcc = xcc_id();
    add_rlx(base + 64 + 64 * xcc, 1u);
    add_rlx(base, 1u);
    st[4] = xcc; st[7] = 0u;
  }
}
DI void gridbar_complete(unsigned* base, ldsp lds, const int tid) {
  if (tid == 0) {
    volatile LAS unsigned* st = (volatile LAS unsigned*)(lds + LDS_BYTES - 64);
    while (ld_rlx(base) < gridDim.x) __builtin_amdgcn_s_sleep(4);
    unsigned nx = 0;
    for (int x = 0; x < 16; ++x) nx += (ld_rlx(base + 64 + 64 * x) != 0u) ? 1u : 0u;
    st[5] = ld_rlx(base + 64 + 64 * st[4]); st[6] = nx;
  }
}
DI void grid_barrier(unsigned* base, ldsp lds, const int tid) {
  asm volatile("s_waitcnt vmcnt(0)" ::: "memory");
  __syncthreads();
  if (tid == 0) {
    volatile LAS unsigned* st = (volatile LAS unsigned*)(lds + LDS_BYTES - 64);
    const unsigned xcc = st[4], nloc = st[5], nx = st[6], k = st[7] + 1u;
    st[7] = k;
    const unsigned old = add_rlx(base + 1152 + 64 * xcc, 1u);
    if (old + 1u == nloc * k) {
      __builtin_amdgcn_fence(__ATOMIC_RELEASE, "agent");
      add_rlx(base + 2240, 1u);
    }
    while (ld_rlx(base + 2240) < nx * k) __builtin_amdgcn_s_sleep(4);
    __builtin_amdgcn_fence(__ATOMIC_ACQUIRE, "agent");
  }
  __syncthreads();
}

__global__ void __launch_bounds__(512) mega(Params p) {
  extern __shared__ __attribute__((aligned(16))) unsigned char lds_raw[];
  const ldsp lds = (ldsp)lds_raw;
  const int tid = threadIdx.x;
  cg::grid_group grid = cg::this_grid();
  const int lo = p.ph_lo, hi = p.ph_hi;
#ifndef PHMASK
#define PHMASK 31
#endif
  if ((PHMASK & 1) && lo <= 0 && 0 < hi) phase0(p, lds, tid);
  unsigned* const gbase = (unsigned*)(p.ws + WS_BAR) + p.bar_idx * BAR_REGION_WORDS;
  gridbar_post(gbase, lds, tid);
  bool gb_ready = false;
#define GRID_BARRIER() do { if (!gb_ready) { gridbar_complete(gbase, lds, tid); gb_ready = true; } grid_barrier(gbase, lds, tid); } while (0)
  if (lo < -1000) grid.sync();
  if (lo <= 0 && 1 < hi) GRID_BARRIER();
  if ((PHMASK & 2) && lo <= 1 && 1 < hi) {
    EpiIn e{(const float*)(p.ws + WS_ROPE), p.out, p.ws};
    gemm_glds<64, 2, 5, EpiIn, true>((const bf16_t*)(p.ws + WS_HB), (const bf16_t*)(p.ws + WS_WINT), MP, MS, NIN, DM, lds, tid, e, p.mode);
    gemm_glds<256, 4, 4>((const bf16_t*)(p.ws + WS_HB), (const bf16_t*)(p.ws + WS_WINT), 0, MP, NIN, DM, lds, tid, e, p.mode);
  }
  if (lo <= 1 && 2 < hi) GRID_BARRIER();
  if ((PHMASK & 4) && lo <= 2 && 2 < hi) phase2(p, lds, tid);
  if (lo <= 2 && 3 < hi) GRID_BARRIER();
  if ((PHMASK & 8) && lo <= 3 && 3 < hi) {
    EpiOut e{p.x_prompt, p.x_sample, (bf16_t*)(p.ws + WS_YPRE)};
    gemm_glds<128, 2, 5>((const bf16_t*)(p.ws + WS_MIX), (const bf16_t*)(p.ws + WS_WOUTT), 0, MP, DM, DM, lds, tid, e, p.mode);
    gemm_glds<64, 2, 5>((const bf16_t*)(p.ws + WS_MIX), (const bf16_t*)(p.ws + WS_WOUTT), MP, MS, DM, DM, lds, tid, e, p.mode);
  }
  if (lo <= 3 && 4 < hi) GRID_BARRIER();
  if ((PHMASK & 16) && lo <= 4 && 4 < hi) phase4(p, tid);
}

extern "C" void kernel_launch(void* const* d_in, const int* in_sizes, int n_in, void* d_out, int out_size, void* d_ws, size_t ws_size, hipStream_t stream) {
  static int grid_blocks = 0;
  if (!grid_blocks) {
    int dev = 0, cus = 0, per_cu = 0;
    hipGetDevice(&dev);
    hipDeviceGetAttribute(&cus, hipDeviceAttributeMultiprocessorCount, dev);
    if (hipFuncSetAttribute((const void*)mega, hipFuncAttributeMaxDynamicSharedMemorySize, LDS_BYTES) != hipSuccess) fprintf(stderr, "hipFuncSetAttribute failed\n");
    if (hipOccupancyMaxActiveBlocksPerMultiprocessor(&per_cu, (const void*)mega, 512, LDS_BYTES) != hipSuccess || per_cu < 1) { fprintf(stderr, "occupancy query gave %d\n", per_cu); per_cu = 1; }
    (void)hipGetLastError();
    if (cus <= 0) cus = 256;
    grid_blocks = cus * per_cu;
  }
  Params p{};
  p.x_prompt = (const float*)d_in[0]; p.x_sample = (const float*)d_in[1]; p.cache_k = (const float*)d_in[2]; p.cache_v = (const float*)d_in[3];
  p.state_pool = (const float*)d_in[4]; p.norm_g = (const float*)d_in[5]; p.w_in = (const float*)d_in[6];
  p.lq1 = (const float*)d_in[7]; p.lk1 = (const float*)d_in[8]; p.lq2 = (const float*)d_in[9]; p.lk2 = (const float*)d_in[10];
  p.subln_g = (const float*)d_in[11]; p.w_pool = (const float*)d_in[12]; p.pool_scale = (const float*)d_in[13]; p.w_out = (const float*)d_in[14]; p.final_g = (const float*)d_in[15];
  p.out = (float*)d_out; p.ws = (unsigned char*)d_ws; p.p2mask = 7;
  (void)hipMemsetAsync((unsigned char*)d_ws + WS_BAR, 0, 2 * BAR_REGION_WORDS * 4, stream);
#if NLAUNCH == 1
#ifndef PROBE_K
  p.ph_lo = 0; p.ph_hi = 5;
  void* args[] = {&p};
  hipError_t e = hipLaunchCooperativeKernel((const void*)mega, dim3(grid_blocks), dim3(512), args, LDS_BYTES, stream);
  if (e != hipSuccess) fprintf(stderr, "cooperative launch failed: %s (grid %d)\n", hipGetErrorString(e), grid_blocks);
#else
  Params p2 = p;
  p.ph_lo = 0; p.ph_hi = PROBE_K + 1; p2.ph_lo = PROBE_K; p2.ph_hi = 5; p2.bar_idx = 1;
#ifdef PROBE_MASK
  p2.p2mask = PROBE_MASK;
#endif
#ifdef PROBE_MODE
  p2.mode = PROBE_MODE; p2.ph_hi = PROBE_K + 1; p.ph_hi = 5;
#endif
  void* args[] = {&p};
  void* args2[] = {&p2};
  hipError_t e = hipLaunchCooperativeKernel((const void*)mega, dim3(grid_blocks), dim3(512), args, LDS_BYTES, stream);
  if (e == hipSuccess) e = hipLaunchCooperativeKernel((const void*)mega, dim3(grid_blocks), dim3(512), args2, LDS_BYTES, stream);
  if (e != hipSuccess) fprintf(stderr, "cooperative launch failed: %s (grid %d)\n", hipGetErrorString(e), grid_blocks);
#endif
#else
  for (int ph = 0; ph < 5; ++ph) {
    p.ph_lo = ph; p.ph_hi = ph + 1;
    hipLaunchKernelGGL(mega, dim3(grid_blocks), dim3(512), LDS_BYTES, stream, p);
  }
#endif
}
```
